# Optimizing an MI355X kernel written in HIP

```python
import jax, jax.numpy as jnp
from jax import lax
import numpy as np

D_MODEL = 1024
BATCH = 4
SEQ = 4096
DEPTH = 4

CONV_DIM = 512
CONV_WIDTH = 31
SB_HEADS = 8
SB_HEAD_DIM = 64
SB_DIM = SB_HEADS * SB_HEAD_DIM
SB_BLOCK = 128
GLA_HEADS = 4
GLA_DK = 128
GLA_DV = 128
GLA_KDIM = GLA_HEADS * GLA_DK
GLA_VDIM = GLA_HEADS * GLA_DV
GLA_GATE_RANK = 16
GLA_GATE_TAU = 16.0
GLA_CHUNK = 64
N_BRANCH = 3
IN_SIZES = (2 * CONV_DIM, 3 * SB_DIM, GLA_KDIM, GLA_KDIM, GLA_VDIM, GLA_VDIM, GLA_GATE_RANK, N_BRANCH * D_MODEL)
IN_COLS = 2 * CONV_DIM + 3 * SB_DIM + 2 * GLA_KDIM + 2 * GLA_VDIM + GLA_GATE_RANK + N_BRANCH * D_MODEL
D_FF = 2816
N_EXPERTS = 8
TOP_K = 2
D_FF_EXPERT = 3584
N_ADA = 6
EPS = 1e-6

kernel_name = 'hybrid_gated_conv_stickbreak_gla_moe'


def rms_norm(x, g):
    xf = x.astype(jnp.float32)
    y = xf * lax.rsqrt(jnp.mean(xf * xf, axis=-1, keepdims=True) + EPS)
    return (y * g.astype(jnp.float32)).astype(x.dtype)


def layer_norm(x, g, b):
    xf = x.astype(jnp.float32)
    mu = jnp.mean(xf, axis=-1, keepdims=True)
    var = jnp.mean(jnp.square(xf - mu), axis=-1, keepdims=True)
    y = (xf - mu) * lax.rsqrt(var + EPS)
    return (y * g.astype(jnp.float32) + b.astype(jnp.float32)).astype(x.dtype)


def heads(t, n):
    return t.reshape(t.shape[0], t.shape[1], n, -1).transpose(0, 2, 1, 3)


def conformer_conv(u, w_dw, b_dw, ln_g, ln_b, w_out):
    a, g = jnp.split(u, 2, axis=-1)
    y = a * jax.nn.sigmoid(g)
    y = lax.conv_general_dilated(
        y, w_dw[:, None, :].astype(y.dtype), window_strides=(1,),
        padding=((CONV_WIDTH - 1, 0),),
        dimension_numbers=('NWC', 'WIO', 'NWC'),
        feature_group_count=CONV_DIM) + b_dw
    y = jax.nn.silu(layer_norm(y, ln_g, ln_b))
    return y @ w_out


def stick_breaking_attention(q, k, v):
    scale = SB_HEAD_DIM ** -0.5
    n_blocks = q.shape[2] // SB_BLOCK
    outs = []
    for i in range(n_blocks):
        t0 = i * SB_BLOCK
        t1 = t0 + SB_BLOCK
        qb = q[:, :, t0:t1]
        kb = k[:, :, :t1]
        vb = v[:, :, :t1]
        z = jnp.einsum('bhtd,bhsd->bhts', qb, kb).astype(jnp.float32) * scale
        t_idx = t0 + jnp.arange(SB_BLOCK)[:, None]
        s_idx = jnp.arange(t1)[None, :]
        causal = s_idx < t_idx
        log_beta = jax.nn.log_sigmoid(z)
        log_keep = jnp.where(causal, jax.nn.log_sigmoid(-z), 0.0)
        log_rest = lax.cumsum(log_keep, axis=3, reverse=True) - log_keep
        att = jnp.where(causal, jnp.exp(log_beta + log_rest), 0.0)
        outs.append(jnp.einsum('bhts,bhsd->bhtd', att.astype(v.dtype), vb))
    return jnp.concatenate(outs, axis=2)


def gla_chunked(q, k, v, log_a):
    B, H, S, dk = q.shape
    dv = v.shape[-1]
    n = S // GLA_CHUNK
    q = q.reshape(B, H, n, GLA_CHUNK, dk)
    k = k.reshape(B, H, n, GLA_CHUNK, dk)
    v = v.reshape(B, H, n, GLA_CHUNK, dv)
    log_a = log_a.reshape(B, H, n, GLA_CHUNK, dk)
    b = jnp.cumsum(log_a, axis=3)
    b_last = b[:, :, :, -1:, :]
    q_dec = q * jnp.exp(b)
    k_inv = k * jnp.exp(-b)
    k_end = k * jnp.exp(b_last - b)
    mask = jnp.tril(jnp.ones((GLA_CHUNK, GLA_CHUNK), dtype=bool))
    scores = jnp.where(mask, jnp.einsum('bhnck,bhnsk->bhncs', q_dec, k_inv), 0.0)
    o_intra = jnp.einsum('bhncs,bhnsv->bhncv', scores, v)
    d_state = jnp.einsum('bhnsk,bhnsv->bhnkv', k_end, v)
    decay = jnp.exp(b_last[:, :, :, 0, :])

    def step(state, inp):
        dec, ds = inp
        return dec[..., None] * state + ds, state

    s0 = jnp.zeros((B, H, dk, dv), jnp.float32)
    _, s_before = lax.scan(step, s0, (jnp.moveaxis(decay, 2, 0), jnp.moveaxis(d_state, 2, 0)))
    s_before = jnp.moveaxis(s_before, 0, 2)
    o_inter = jnp.einsum('bhnck,bhnkv->bhncv', q_dec, s_before)
    return (o_intra + o_inter).reshape(B, H, S, dv)


def hybrid_mixer(h, w_in, gla_a2, gla_a_b, conv_dw, conv_dw_b, conv_ln_g, conv_ln_b,
                 gla_norm_g, w_conv_out, w_sb_out, w_gla_out, w_o):
    B, S, _ = h.shape
    z = h @ w_in
    offs = []
    acc = 0
    for n in IN_SIZES[:-1]:
        acc += n
        offs.append(acc)
    u_conv, sb_qkv, gq, gk, gv, gg, g_lr, gates = jnp.split(z, offs, axis=-1)
    y_a = conformer_conv(u_conv, conv_dw, conv_dw_b, conv_ln_g, conv_ln_b, w_conv_out)
    sq, sk, sv = jnp.split(sb_qkv, 3, axis=-1)
    o_b = stick_breaking_attention(heads(sq, SB_HEADS), heads(sk, SB_HEADS), heads(sv, SB_HEADS))
    y_b = o_b.transpose(0, 2, 1, 3).reshape(B, S, SB_DIM) @ w_sb_out
    log_a = jax.nn.log_sigmoid((g_lr @ gla_a2 + gla_a_b).astype(jnp.float32)) / GLA_GATE_TAU
    o_c = gla_chunked(heads(gq, GLA_HEADS).astype(jnp.float32) * (GLA_DK ** -0.5),
                      heads(gk, GLA_HEADS).astype(jnp.float32),
                      heads(gv, GLA_HEADS).astype(jnp.float32),
                      heads(log_a, GLA_HEADS))
    o_c = rms_norm(o_c.transpose(0, 2, 1, 3), gla_norm_g.reshape(GLA_HEADS, GLA_DV)).astype(h.dtype)
    y_c = (o_c.reshape(B, S, GLA_VDIM) * jax.nn.silu(gg)) @ w_gla_out
    g_a, g_b, g_c = jnp.split(jax.nn.sigmoid(gates), N_BRANCH, axis=-1)
    return (g_a * y_a + g_b * y_b + g_c * y_c) @ w_o


def swiglu(h, w_gate, w_up, w_down):
    return (jax.nn.silu(h @ w_gate) * (h @ w_up)) @ w_down


def moe_swiglu(h, router_w, w_gate, w_up, w_down):
    logits = (h @ router_w).astype(jnp.float32)
    top_val, top_idx = lax.top_k(logits, TOP_K)
    probs = jax.nn.softmax(top_val, axis=-1)
    combine = jnp.sum(jax.nn.one_hot(top_idx, N_EXPERTS, dtype=jnp.float32) * probs[..., None], axis=-2)
    out = jnp.zeros_like(h)
    for e in range(N_EXPERTS):
        out = out + combine[..., e:e + 1].astype(h.dtype) * swiglu(h, w_gate[e], w_up[e], w_down[e])
    return out


def setup_inputs(seed: int = 0) -> dict:
    key = jax.random.key(seed)
    ks = iter(jax.random.split(key, 40))

    def nrm(shape, scale):
        return jax.random.normal(next(ks), shape, jnp.float32) * scale

    def gain(shape):
        return 1.0 + nrm(shape, 0.02)

    L = DEPTH
    ND = (DEPTH + 1) // 2
    NM = DEPTH // 2
    return {
        'x': nrm((BATCH, SEQ, D_MODEL), 1.0),
        'c': nrm((BATCH, D_MODEL), 1.0),
        'ada_w': nrm((L, D_MODEL, N_ADA * D_MODEL), 0.5 * D_MODEL ** -0.5),
        'ada_b': nrm((L, N_ADA * D_MODEL), 0.02),
        'mix_pre_g': gain((L, D_MODEL)),
        'mix_post_g': gain((L, D_MODEL)),
        'ffn_pre_g': gain((L, D_MODEL)),
        'ffn_post_g': gain((L, D_MODEL)),
        'w_in': nrm((L, D_MODEL, IN_COLS), D_MODEL ** -0.5),
        'gla_a2': nrm((L, GLA_GATE_RANK, GLA_KDIM), GLA_GATE_RANK ** -0.5),
        'gla_a_b': nrm((L, GLA_KDIM), 0.02),
        'conv_dw': nrm((L, CONV_WIDTH, CONV_DIM), CONV_WIDTH ** -0.5),
        'conv_dw_b': nrm((L, CONV_DIM), 0.02),
        'conv_ln_g': gain((L, CONV_DIM)),
        'conv_ln_b': nrm((L, CONV_DIM), 0.02),
        'gla_norm_g': gain((L, GLA_VDIM)),
        'w_conv_out': nrm((L, CONV_DIM, D_MODEL), CONV_DIM ** -0.5),
        'w_sb_out': nrm((L, SB_DIM, D_MODEL), SB_DIM ** -0.5),
        'w_gla_out': nrm((L, GLA_VDIM, D_MODEL), GLA_VDIM ** -0.5),
        'w_o': nrm((L, D_MODEL, D_MODEL), D_MODEL ** -0.5),
        'ffn_w_gate': nrm((ND, D_MODEL, D_FF), D_MODEL ** -0.5),
        'ffn_w_up': nrm((ND, D_MODEL, D_FF), D_MODEL ** -0.5),
        'ffn_w_down': nrm((ND, D_FF, D_MODEL), D_FF ** -0.5),
        'router_w': nrm((NM, D_MODEL, N_EXPERTS), D_MODEL ** -0.5),
        'moe_w_gate': nrm((NM, N_EXPERTS, D_MODEL, D_FF_EXPERT), D_MODEL ** -0.5),
        'moe_w_up': nrm((NM, N_EXPERTS, D_MODEL, D_FF_EXPERT), D_MODEL ** -0.5),
        'moe_w_down': nrm((NM, N_EXPERTS, D_FF_EXPERT, D_MODEL), D_FF_EXPERT ** -0.5),
    }


def reference(x, c, ada_w, ada_b, mix_pre_g, mix_post_g, ffn_pre_g, ffn_post_g, w_in,
              gla_a2, gla_a_b, conv_dw, conv_dw_b, conv_ln_g, conv_ln_b, gla_norm_g,
              w_conv_out, w_sb_out, w_gla_out, w_o, ffn_w_gate, ffn_w_up, ffn_w_down,
              router_w, moe_w_gate, moe_w_up, moe_w_down):
    cond = jax.nn.silu(c)
    for l in range(DEPTH):
        mod = (cond @ ada_w[l] + ada_b[l])[:, None, :]
        sh_m, sc_m, g_m, sh_f, sc_f, g_f = jnp.split(mod, N_ADA, axis=-1)
        h = rms_norm(x, mix_pre_g[l]) * (1 + sc_m) + sh_m
        y = hybrid_mixer(h, w_in[l], gla_a2[l], gla_a_b[l], conv_dw[l], conv_dw_b[l],
                         conv_ln_g[l], conv_ln_b[l], gla_norm_g[l], w_conv_out[l],
                         w_sb_out[l], w_gla_out[l], w_o[l])
        x = x + g_m * rms_norm(y, mix_post_g[l])
        h = rms_norm(x, ffn_pre_g[l]) * (1 + sc_f) + sh_f
        j = l // 2
        if l % 2 == 0:
            y = swiglu(h, ffn_w_gate[j], ffn_w_up[j], ffn_w_down[j])
        else:
            y = moe_swiglu(h, router_w[j], moe_w_gate[j], moe_w_up[j], moe_w_down[j])
        x = x + g_f * rms_norm(y, ffn_post_g[l])
    return x
```

```cpp
#include <hip/hip_runtime.h>
#include <stdint.h>
#include <stdio.h>

#ifndef DBG
#define DBG 0
#endif

#define LAS __attribute__((address_space(3)))
typedef unsigned short bf16_t;
typedef short bf16x8 __attribute__((ext_vector_type(8)));
typedef short s16x4 __attribute__((ext_vector_type(4)));
typedef float f32x2 __attribute__((ext_vector_type(2)));
typedef float f32x4 __attribute__((ext_vector_type(4)));
typedef float f32x16 __attribute__((ext_vector_type(16)));
typedef unsigned u32x2 __attribute__((ext_vector_type(2)));
typedef unsigned u32x4 __attribute__((ext_vector_type(4)));

constexpr int NB = 4, SEQ = 4096, DM = 1024, MTOK = NB * SEQ, NLAYER = 4;
constexpr int IN_SRC = 7696;
constexpr int NIN = 7936;
constexpr int ZP = 7424;
constexpr int ZC_GLU = 0, ZC_SQ = 512, ZC_SK = 1024, ZC_SV = 1536, ZC_GQ = 2048, ZC_GK = 2560, ZC_GV = 3072, ZC_GG = 3584, ZC_GATE = 4096, ZC_GLR = 7168;
constexpr int ABCP = 1536;
constexpr int DFF = 2816, DFFE = 3584, NEXP = 8;
constexpr int MOE_ROWS = 34816;
constexpr float EPS = 1e-6f;
constexpr float LOG2E = 1.4426950408889634f, LN2 = 0.6931471805599453f;

constexpr size_t WS_CTL = 0, CTL_BYTES = 131072;
constexpr size_t WS_MODP = WS_CTL + CTL_BYTES;
constexpr size_t WS_MODF = WS_MODP + (size_t)8 * 98304 * 4;
constexpr size_t WS_DECAY = WS_MODF + (size_t)98304 * 4;
constexpr size_t WS_LIST = WS_DECAY + (size_t)1024 * 128 * 4;
constexpr size_t WS_TOKE = WS_LIST + (size_t)8 * 16384 * 4;
constexpr size_t WS_TOKS = WS_TOKE + (size_t)16384 * 4;
constexpr size_t WS_TOKP = WS_TOKS + (size_t)16384 * 8;
constexpr size_t WS_WIN = WS_TOKP + (size_t)16384 * 8;
constexpr size_t WS_WCAT = WS_WIN + (size_t)4 * NIN * 1024 * 2;
constexpr size_t WS_WO = WS_WCAT + (size_t)4 * 1024 * 1536 * 2;
constexpr size_t WS_WGU = WS_WO + (size_t)4 * 1024 * 1024 * 2;
constexpr size_t WS_WDN = WS_WGU + (size_t)2 * 5632 * 1024 * 2;
constexpr size_t WS_WMGU = WS_WDN + (size_t)2 * 1024 * 2816 * 2;
constexpr size_t WS_WMDN = WS_WMGU + (size_t)16 * 7168 * 1024 * 2;
constexpr size_t WS_R1 = WS_WMDN + (size_t)16 * 1024 * 3584 * 2;
constexpr size_t WS_H = WS_R1 + (size_t)MOE_ROWS * 3584 * 2;
constexpr size_t WS_RY = WS_H + (size_t)MTOK * 1024 * 2;
constexpr size_t WS_RM = WS_RY + (size_t)MOE_ROWS * 1024 * 2;
constexpr size_t WS_MRG = WS_RM + (size_t)MTOK * ABCP * 2;
constexpr size_t WS_OEX = WS_MRG + (size_t)MTOK * 1024 * 2;
constexpr size_t WS_END = WS_OEX + (size_t)4 * 8 * 256 * 1024 * 4;
constexpr size_t WS_HG8 = WS_OEX + (size_t)16 * 1024 * 1024;
constexpr int CW_BAR = 4096;
constexpr int CW_CNT = 8192;
constexpr int CW_WCNT = 28672;

constexpr int RING_BYTES = 131072;
constexpr int MISC_OFF = RING_BYTES;
constexpr int TAB_OFF = MISC_OFF + 64;
constexpr int BASE_OFF = TAB_OFF + 256;
constexpr int GSUM_OFF = BASE_OFF + 8 * 257 * 4;
constexpr int LDS_BYTES = GSUM_OFF + 256;

__device__ __forceinline__ int ltid() { int t = threadIdx.x; asm volatile("" : "+v"(t)); return t; }
__device__ __forceinline__ int lbid() { int t = blockIdx.x; asm volatile("" : "+s"(t)); return t; }
__device__ __forceinline__ int lgrid() { int t = gridDim.x; asm volatile("" : "+s"(t)); return t; }
__device__ __forceinline__ unsigned f2bf(float f) { unsigned u = __builtin_bit_cast(unsigned, f); return (u + 0x7fffu + ((u >> 16) & 1u)) >> 16; }
__device__ __forceinline__ float bf2f(unsigned b) { return __builtin_bit_cast(float, b << 16); }
__device__ __forceinline__ float bflo(unsigned w) { return __builtin_bit_cast(float, w << 16); }
__device__ __forceinline__ float bfhi(unsigned w) { return __builtin_bit_cast(float, w & 0xffff0000u); }
typedef __bf16 bf16x2_t __attribute__((ext_vector_type(2)));
__device__ __forceinline__ unsigned pk2(float lo, float hi) { f32x2 v = {lo, hi}; bf16x2_t b = __builtin_convertvector(v, bf16x2_t); return __builtin_bit_cast(unsigned, b); }
__device__ __forceinline__ float sat8(float x) { return __builtin_amdgcn_fmed3f(x, -448.f, 448.f); }
__device__ __forceinline__ unsigned pk8x4(float a, float b, float c, float d) { return (unsigned)__builtin_amdgcn_cvt_pk_fp8_f32(sat8(c), sat8(d), __builtin_amdgcn_cvt_pk_fp8_f32(sat8(a), sat8(b), 0, false), true); }
__device__ __forceinline__ float ex2(float x) { return __builtin_amdgcn_exp2f(x); }
__device__ __forceinline__ float lg2(float x) { return __builtin_amdgcn_logf(x); }
__device__ __forceinline__ float rcp(float x) { return __builtin_amdgcn_rcpf(x); }
__device__ __forceinline__ float sigm(float x) { return rcp(1.f + ex2(-LOG2E * x)); }
__device__ __forceinline__ float silu(float x) { return x * sigm(x); }
__device__ __forceinline__ float logsig(float u) { return fminf(u, 0.f) - LN2 * lg2(1.f + ex2(-LOG2E * fabsf(u))); }
__device__ __forceinline__ float wave_sum(float v) {
#pragma unroll
    for (int o = 1; o < 64; o <<= 1) v += __shfl_xor(v, o);
    return v;
}
__device__ __forceinline__ int crow(int r, int hi) { return (r & 3) + 8 * (r >> 2) + 4 * hi; }
__device__ __forceinline__ s16x4 trrd(const LAS unsigned char* p) { typedef short v4i16_t __attribute__((ext_vector_type(4))); return __builtin_bit_cast(s16x4, __builtin_amdgcn_ds_read_tr16_b64_v4i16((LAS v4i16_t*)p)); }
__device__ __forceinline__ bf16x8 cat8(s16x4 a, s16x4 b) { return (bf16x8){a[0], a[1], a[2], a[3], b[0], b[1], b[2], b[3]}; }

#define XB_TMO      128
#define XB_XCNT(j)  (256  + 64 * (j))
#define XB_XSUB(j)  (1280 + 64 * (j))
#define XB_XGEN(j)  (2304 + 64 * (j))
#define XB_TOP      3328
#define XB_TOPGEN   3392
#define XCD_BAR_WORDS 3456
#define XB_SPIN_CAP (1u << 18)
__device__ __forceinline__ unsigned xb_ld(unsigned* p)              { return __hip_atomic_load(p, __ATOMIC_RELAXED, __HIP_MEMORY_SCOPE_AGENT); }
__device__ __forceinline__ unsigned xb_add(unsigned* p, unsigned v) { return __hip_atomic_fetch_add(p, v, __ATOMIC_RELAXED, __HIP_MEMORY_SCOPE_AGENT); }
__device__ __forceinline__ unsigned xb_xcc_id() { return (unsigned)__builtin_amdgcn_s_getreg((3 << 11) | 20) & 0xFu; }
#define XB_SPIN(cond, bar) do { unsigned _sp = 0; while (cond) { __builtin_amdgcn_s_sleep(1); \
    if ((++_sp & 255u) == 0u) { if (xb_ld(&(bar)[XB_TMO])) break; if (_sp > XB_SPIN_CAP) { atomicAdd(&(bar)[XB_TMO], 1u); break; } } } } while (0)
struct XcdBarrier { unsigned* bar; unsigned x; volatile LAS unsigned* st; };
__device__ __forceinline__ XcdBarrier xcd_barrier_post(unsigned* bar, volatile LAS unsigned* st) {
    XcdBarrier b; b.bar = bar; b.x = xb_xcc_id(); b.st = st;
    if (threadIdx.x == 0) (void)xb_add(&bar[XB_XCNT(b.x)], 1u);
    return b;
}
__device__ __forceinline__ void xcd_barrier_complete(unsigned* bar, unsigned x, unsigned& nloc, unsigned& nx) {
    const unsigned G = gridDim.x * gridDim.y * gridDim.z;
    unsigned sum, cnt, mine, sp = 0u;
    for (;;) {
        sum = 0u; cnt = 0u; mine = 0u;
#pragma unroll
        for (unsigned j = 0; j < 16; ++j) { const unsigned c = xb_ld(&bar[XB_XCNT(j)]); sum += c; cnt += (c > 0u) ? 1u : 0u; mine = (j == x) ? c : mine; }
        if (sum == G) break;
        __builtin_amdgcn_s_sleep(1);
        if ((++sp & 255u) == 0u) { if (xb_ld(&bar[XB_TMO])) break; if (sp > XB_SPIN_CAP) { atomicAdd(&bar[XB_TMO], 1u); break; } }
    }
    nloc = mine > 0u ? mine : 1u; nx = cnt > 0u ? cnt : 1u;
}
__device__ __forceinline__ void xcd_barrier(const XcdBarrier& b) {
    asm volatile("s_waitcnt vmcnt(0)" ::: "memory");
    __syncthreads();
    if (threadIdx.x == 0) {
        unsigned* bar = b.bar;
        __builtin_amdgcn_s_waitcnt(0);
        unsigned nloc = b.st[0], nx = b.st[1];
        if (nloc == 0u) { xcd_barrier_complete(bar, b.x, nloc, nx); b.st[0] = nloc; b.st[1] = nx; }
        const unsigned old = xb_add(&bar[XB_XSUB(b.x)], 1u);
        const unsigned gen = old / nloc;
        if (old + 1u == (gen + 1u) * nloc) {
            __builtin_amdgcn_fence(__ATOMIC_RELEASE, "agent");
            asm volatile("s_waitcnt vmcnt(0)" ::: "memory");
            const unsigned og = xb_add(&bar[XB_TOP], 1u);
            const unsigned tg = og / nx;
            if (og + 1u == (tg + 1u) * nx) xb_add(&bar[XB_TOPGEN], 1u);
            else XB_SPIN(xb_ld(&bar[XB_TOPGEN]) == tg, bar);
            __builtin_amdgcn_fence(__ATOMIC_ACQUIRE, "agent");
            xb_add(&bar[XB_XGEN(b.x)], 1u);
            asm volatile("s_waitcnt vmcnt(0)" ::: "memory");
        } else {
            XB_SPIN(xb_ld(&bar[XB_XGEN(b.x)]) == gen, bar);
            __builtin_amdgcn_fence(__ATOMIC_ACQUIRE, "agent");
            asm volatile("s_waitcnt vmcnt(0)" ::: "memory");
        }
    }
    __syncthreads();
}
namespace pg8 {
constexpr int BM = 256, BK = 64, HALF = 128, HTB = HALF * BK * 2, STAGE_BYTES = 8 * HTB, NXCD = 8, WGM = 8;
__host__ __device__ __forceinline__ int lds_byte(int r, int c) { const int st = (r >> 4) * 2 + (c >> 5), rr = r & 15, cc = c & 31, ob = rr * 64 + cc * 2; return st * 1024 + (ob ^ (((ob >> 9) & 1) << 5)); }
__host__ __device__ __forceinline__ void stage_rc(int b, int& R, int& C) { const int st = b / 1024, sb = b % 1024, swz = sb ^ (((sb >> 9) & 1) << 5); R = (st >> 1) * 16 + swz / 64; C = (st & 1) * 32 + (swz % 64) / 2; }
__host__ __device__ __forceinline__ int perm32(int rho) { const int n = rho >> 4, i = rho & 15; return 8 * (i >> 2) + 4 * n + (i & 3); }

struct Unit { int pm, pn, e, rt; };

__device__ __forceinline__ bool tile_of(long L, int nM, int nN, int& pm, int& pn) {
    const int nwg = nM * nN; if (L >= nwg) return false;
    int wgid = (int)L; { const int q = nwg / NXCD, r = nwg % NXCD, xcd = wgid % NXCD, off = wgid / NXCD; wgid = (xcd < r ? xcd * (q + 1) : r * (q + 1) + (xcd - r) * q) + off; }
    const int nig = WGM * nN, gid = wgid / nig, fm = gid * WGM, gsz = (nM - fm) < WGM ? (nM - fm) : WGM;
    pm = fm + ((wgid % nig) % gsz); pn = (wgid % nig) / gsz; return true;
}
struct DenseSched {
    static constexpr bool GATHER = false;
    int nM, nN, G, c; const char* A; const char* Bt; size_t tA, tB;
    __device__ __forceinline__ bool next(int i, Unit& u) const { u.e = 0; u.rt = 0; return tile_of((long)i * G + c, nM, nN, u.pm, u.pn); }
    __device__ __forceinline__ const char* a_ptr(const Unit& u) const { return A + (size_t)u.pm * tA; }
    __device__ __forceinline__ const char* b_ptr(const Unit& u) const { return Bt + (size_t)u.pn * tB; }
    __device__ __forceinline__ unsigned row_tok(const Unit&, int) const { return 0u; }
};
struct InSched {
    static constexpr bool GATHER = false;
    int G, c; const char* A; const char* Bt; size_t tA, tB; int lo, hi;
    __device__ __forceinline__ bool next(int i, Unit& u) const { const int L = lo + i * G + c; u.e = 0; u.rt = 0; if (L >= hi) return false;
        const int ci = L >> 6; u.pm = L & 63; u.pn = ci < 12 ? 18 + ci : ci < 16 ? ci - 12 : ci < 18 ? ci : ci < 30 ? ci - 14 : 30; return true; }
    __device__ __forceinline__ const char* a_ptr(const Unit& u) const { return A + (size_t)u.pm * tA; }
    __device__ __forceinline__ const char* b_ptr(const Unit& u) const { return Bt + (size_t)u.pn * tB; }
    __device__ __forceinline__ unsigned row_tok(const Unit&, int) const { return 0u; }
};
struct CatSched {
    static constexpr bool GATHER = false;
    int G, c; const char* A; const char* Bt; size_t tA, tB;
    __device__ __forceinline__ bool next(int i, Unit& u) const { u.e = i % 3; u.rt = 0; return tile_of((long)(i / 3) * G + c, 64, 4, u.pm, u.pn); }
    __device__ __forceinline__ const char* a_ptr(const Unit& u) const { return A + (size_t)u.pm * tA + (size_t)u.e * 1024; }
    __device__ __forceinline__ const char* b_ptr(const Unit& u) const { return Bt + (size_t)u.pn * tB + (size_t)u.e * 1024; }
    __device__ __forceinline__ unsigned row_tok(const Unit&, int) const { return 0u; }
};
template <bool GATH> struct MoeSched {
    static constexpr bool GATHER = GATH;
    int nN, G, c; const LAS int* tab; const char* A; const char* Bt; size_t tA, tB, eB; const int* list; unsigned rowbytes; int cap;
    __device__ __forceinline__ bool next(int i, Unit& u) const {
        const int nM = tab[8] < cap ? tab[8] : cap; int pmg, pn; if (!tile_of((long)i * G + c, nM, nN, pmg, pn)) return false;
        int e = 0;
#pragma unroll
        for (int j = 1; j < 8; ++j) e += (pmg >= tab[j]) ? 1 : 0;
        u.pm = pmg; u.pn = pn; u.e = e; u.rt = pmg - tab[e]; return true;
    }
    __device__ __forceinline__ const char* a_ptr(const Unit& u) const { return GATH ? A : A + (size_t)u.pm * tA; }
    __device__ __forceinline__ const char* b_ptr(const Unit& u) const { return Bt + (size_t)u.e * eB + (size_t)u.pn * tB; }
    __device__ __forceinline__ unsigned row_tok(const Unit& u, int r) const { const int slot = u.rt * 256 + r; if (slot >= tab[16 + u.e]) return 0u;
        const LAS int* B = (const LAS int*)((const LAS unsigned char*)tab + (BASE_OFF - TAB_OFF)) + u.e * 257; int lo = 0;
#pragma unroll
        for (int st = 128; st >= 1; st >>= 1) lo += (B[lo + st] <= slot) ? st : 0;
        return (unsigned)list[(lo * 8 + u.e) * 64 + (slot - B[lo])]; }
};

struct MoeTailSched {
    static constexpr bool GATHER = false; static constexpr int SK = 2, KS = 1792;
    int G, c; const LAS int* tab; const char* A; const char* Bt; size_t tA, tB, eB;
    __device__ __forceinline__ bool next(int i, Unit& u) const {
        const int nx = tab[8] - 128; const long L = (long)i * G + c; if (L >= (long)nx * 4 * SK) return false;
        const int part = (int)(L % SK), rest = (int)(L / SK), pn = rest & 3, pmx = rest >> 2, pmg = 128 + pmx;
        int e = 0;
#pragma unroll
        for (int j = 1; j < 8; ++j) e += (pmg >= tab[j]) ? 1 : 0;
        u.pm = part * 8 + pmx; u.pn = pn; u.e = e; u.rt = pmx * SK + part; return true;
    }
    __device__ __forceinline__ const char* a_ptr(const Unit& u) const { return A + (size_t)(128 + u.rt / SK) * tA + (size_t)(u.rt % SK) * KS; }
    __device__ __forceinline__ const char* b_ptr(const Unit& u) const { return Bt + (size_t)u.e * eB + (size_t)u.pn * tB + (size_t)(u.rt % SK) * KS; }
    __device__ __forceinline__ unsigned row_tok(const Unit&, int) const { return 0u; }
};

struct EpiF32 {
    static constexpr bool PERM = false; static constexpr bool AFTER_DRAIN = false; static constexpr bool F8 = false;
    float* C; int ldc;
    __device__ __forceinline__ void operator()(const f32x4 (&acc)[2][2][4][2], const Unit& u, int wr, int wc, int fr, int fq) const {
        const int row0 = u.pm * BM + wr * 64 + fr, col0 = u.pn * BM + wc * 32 + 4 * fq;
#pragma unroll
        for (int ai = 0; ai < 2; ++ai)
#pragma unroll
            for (int m = 0; m < 4; ++m) { float* rowp = C + (size_t)(row0 + ai * HALF + m * 16) * ldc + col0;
#pragma unroll
                for (int bj = 0; bj < 2; ++bj)
#pragma unroll
                    for (int n = 0; n < 2; ++n) *(f32x4*)(rowp + bj * HALF + n * 16) = acc[ai][bj][m][n]; }
    }
};
struct EpiF32F8 {
    static constexpr bool PERM = false; static constexpr bool AFTER_DRAIN = false; static constexpr bool F8 = true;
    float* C; int ldc;
    __device__ __forceinline__ void operator()(const f32x4 (&acc)[2][2][4][2], const Unit& u, int wr, int wc, int fr, int fq) const {
        const int row0 = u.pm * BM + wr * 64 + fr, col0 = u.pn * BM + wc * 32 + 4 * fq;
#pragma unroll
        for (int ai = 0; ai < 2; ++ai)
#pragma unroll
            for (int m = 0; m < 4; ++m) { float* rowp = C + (size_t)(row0 + ai * HALF + m * 16) * ldc + col0;
#pragma unroll
                for (int bj = 0; bj < 2; ++bj)
#pragma unroll
                    for (int n = 0; n < 2; ++n) *(f32x4*)(rowp + bj * HALF + n * 16) = acc[ai][bj][m][n]; }
    }
};
struct EpiBf16 {
    static constexpr bool PERM = true; static constexpr bool AFTER_DRAIN = false; static constexpr bool F8 = false;
    bf16_t* O; int ldc;
    __device__ __forceinline__ void operator()(const f32x4 (&acc)[2][2][4][2], const Unit& u, int wr, int wc, int fr, int fq) const {
        const int row0 = u.pm * BM + wr * 64 + fr, col0 = u.pn * BM + wc * 32 + 8 * fq;
#pragma unroll
        for (int ai = 0; ai < 2; ++ai)
#pragma unroll
            for (int m = 0; m < 4; ++m) { bf16_t* rowp = O + (size_t)(row0 + ai * HALF + m * 16) * ldc + col0;
#pragma unroll
                for (int bj = 0; bj < 2; ++bj) { const f32x4 v0 = acc[ai][bj][m][0], v1 = acc[ai][bj][m][1];
                    u32x4 w; w.x = pk2(v0[0], v0[1]); w.y = pk2(v0[2], v0[3]); w.z = pk2(v1[0], v1[1]); w.w = pk2(v1[2], v1[3]);
                    *(u32x4*)(rowp + bj * HALF) = w; } }
    }
};
struct EpiBf16F8 {
    static constexpr bool PERM = true; static constexpr bool AFTER_DRAIN = false; static constexpr bool F8 = true;
    bf16_t* O; int ldc;
    __device__ __forceinline__ void operator()(const f32x4 (&acc)[2][2][4][2], const Unit& u, int wr, int wc, int fr, int fq) const {
        const int row0 = u.pm * BM + wr * 64 + fr, col0 = u.pn * BM + wc * 32 + 8 * fq;
#pragma unroll
        for (int ai = 0; ai < 2; ++ai)
#pragma unroll
            for (int m = 0; m < 4; ++m) { bf16_t* rowp = O + (size_t)(row0 + ai * HALF + m * 16) * ldc + col0;
#pragma unroll
                for (int bj = 0; bj < 2; ++bj) { const f32x4 v0 = acc[ai][bj][m][0], v1 = acc[ai][bj][m][1];
                    u32x4 w; w.x = pk2(v0[0], v0[1]); w.y = pk2(v0[2], v0[3]); w.z = pk2(v1[0], v1[1]); w.w = pk2(v1[2], v1[3]);
                    *(u32x4*)(rowp + bj * HALF) = w; } }
    }
};
struct EpiIn {
    static constexpr bool PERM = true; static constexpr bool AFTER_DRAIN = false; static constexpr bool F8 = false;
    bf16_t* Z;
    __device__ __forceinline__ void operator()(const f32x4 (&acc)[2][2][4][2], const Unit& u, int wr, int wc, int fr, int fq) const {
        const int row0 = u.pm * BM + wr * 64 + fr, c0 = u.pn * BM + wc * 32 + 8 * fq;
        if (u.pn < 4) {
#pragma unroll
            for (int ai = 0; ai < 2; ++ai)
#pragma unroll
                for (int m = 0; m < 4; ++m) { bf16_t* rowp = Z + (size_t)(row0 + ai * HALF + m * 16) * ZP + u.pn * HALF + wc * 32 + 8 * fq;
                    const f32x4 a0 = acc[ai][0][m][0], a1 = acc[ai][0][m][1], g0 = acc[ai][1][m][0], g1 = acc[ai][1][m][1];
                    u32x4 w; w.x = pk2(a0[0] * sigm(g0[0]), a0[1] * sigm(g0[1])); w.y = pk2(a0[2] * sigm(g0[2]), a0[3] * sigm(g0[3]));
                    w.z = pk2(a1[0] * sigm(g1[0]), a1[1] * sigm(g1[1])); w.w = pk2(a1[2] * sigm(g1[2]), a1[3] * sigm(g1[3]));
                    *(u32x4*)rowp = w; }
        } else {
            int act = 0;
            if (u.pn == 16 || u.pn == 17) act = 1; else if (u.pn >= 18 && u.pn < 30) act = 2;
#pragma unroll
            for (int ai = 0; ai < 2; ++ai)
#pragma unroll
                for (int m = 0; m < 4; ++m) { bf16_t* rowp = Z + (size_t)(row0 + ai * HALF + m * 16) * ZP + (c0 - 512);
#pragma unroll
                    for (int bj = 0; bj < 2; ++bj) { f32x4 v0 = acc[ai][bj][m][0], v1 = acc[ai][bj][m][1];
                        if (act == 1) {
#pragma unroll
                            for (int j = 0; j < 4; ++j) { v0[j] = silu(v0[j]); v1[j] = silu(v1[j]); } }
                        else if (act == 2) {
#pragma unroll
                            for (int j = 0; j < 4; ++j) { v0[j] = sigm(v0[j]); v1[j] = sigm(v1[j]); } }
                        u32x4 w; w.x = pk2(v0[0], v0[1]); w.y = pk2(v0[2], v0[3]); w.z = pk2(v1[0], v1[1]); w.w = pk2(v1[2], v1[3]);
                        *(u32x4*)(rowp + bj * HALF) = w; } }
        }
    }
};
struct EpiInF8 {
    static constexpr bool PERM = true; static constexpr bool AFTER_DRAIN = false; static constexpr bool F8 = true;
    bf16_t* Z;
    __device__ __forceinline__ void operator()(const f32x4 (&acc)[2][2][4][2], const Unit& u, int wr, int wc, int fr, int fq) const {
        const int row0 = u.pm * BM + wr * 64 + fr, c0 = u.pn * BM + wc * 32 + 8 * fq;
        if (u.pn < 4) {
#pragma unroll
            for (int ai = 0; ai < 2; ++ai)
#pragma unroll
                for (int m = 0; m < 4; ++m) { bf16_t* rowp = Z + (size_t)(row0 + ai * HALF + m * 16) * ZP + u.pn * HALF + wc * 32 + 8 * fq;
                    const f32x4 a0 = acc[ai][0][m][0], a1 = acc[ai][0][m][1], g0 = acc[ai][1][m][0], g1 = acc[ai][1][m][1];
                    u32x4 w; w.x = pk2(a0[0] * sigm(g0[0]), a0[1] * sigm(g0[1])); w.y = pk2(a0[2] * sigm(g0[2]), a0[3] * sigm(g0[3]));
                    w.z = pk2(a1[0] * sigm(g1[0]), a1[1] * sigm(g1[1])); w.w = pk2(a1[2] * sigm(g1[2]), a1[3] * sigm(g1[3]));
                    *(u32x4*)rowp = w; }
        } else {
            int act = 0;
            if (u.pn == 16 || u.pn == 17) act = 1; else if (u.pn >= 18 && u.pn < 30) act = 2;
#pragma unroll
            for (int ai = 0; ai < 2; ++ai)
#pragma unroll
                for (int m = 0; m < 4; ++m) { bf16_t* rowp = Z + (size_t)(row0 + ai * HALF + m * 16) * ZP + (c0 - 512);
#pragma unroll
                    for (int bj = 0; bj < 2; ++bj) { f32x4 v0 = acc[ai][bj][m][0], v1 = acc[ai][bj][m][1];
                        if (act == 1) {
#pragma unroll
                            for (int j = 0; j < 4; ++j) { v0[j] = silu(v0[j]); v1[j] = silu(v1[j]); } }
                        else if (act == 2) {
#pragma unroll
                            for (int j = 0; j < 4; ++j) { v0[j] = sigm(v0[j]); v1[j] = sigm(v1[j]); } }
                        u32x4 w; w.x = pk2(v0[0], v0[1]); w.y = pk2(v0[2], v0[3]); w.z = pk2(v1[0], v1[1]); w.w = pk2(v1[2], v1[3]);
                        *(u32x4*)(rowp + bj * HALF) = w; } }
        }
    }
};
struct EpiMerge {
    static constexpr bool PERM = true; static constexpr bool AFTER_DRAIN = false; static constexpr bool F8 = false;
    const bf16_t* Zg0; bf16_t* MRG;
    __device__ __forceinline__ void operator()(const f32x4 (&acc)[2][2][4][2], const Unit& u, int wr, int wc, int fr, int fq) const {
        const int row0 = u.pm * BM + wr * 64 + fr, c0 = u.pn * BM + wc * 32 + 8 * fq; const bf16_t* Zg = Zg0 + 1024 * u.e; const int accum = u.e;
#pragma unroll
        for (int ai = 0; ai < 2; ++ai)
#pragma unroll
            for (int m = 0; m < 4; ++m) { const size_t row = (size_t)(row0 + ai * HALF + m * 16);
#pragma unroll
                for (int bj = 0; bj < 2; ++bj) { const f32x4 v0 = acc[ai][bj][m][0], v1 = acc[ai][bj][m][1];
                    const u32x4 g = *(const u32x4*)(Zg + row * ZP + c0 + bj * HALF);
                    bf16_t* op = MRG + row * 1024 + c0 + bj * HALF;
                    u32x4 p = (u32x4){0u, 0u, 0u, 0u}; if (accum) p = *(const u32x4*)op;
                    u32x4 w;
                    w.x = pk2(bflo(p.x) + bflo(g.x) * v0[0], bfhi(p.x) + bfhi(g.x) * v0[1]); w.y = pk2(bflo(p.y) + bflo(g.y) * v0[2], bfhi(p.y) + bfhi(g.y) * v0[3]);
                    w.z = pk2(bflo(p.z) + bflo(g.z) * v1[0], bfhi(p.z) + bfhi(g.z) * v1[1]); w.w = pk2(bflo(p.w) + bflo(g.w) * v1[2], bfhi(p.w) + bfhi(g.w) * v1[3]);
                    *(u32x4*)op = w; } }
    }
};
struct EpiSwiglu {
    static constexpr bool PERM = true; static constexpr bool AFTER_DRAIN = false; static constexpr bool F8 = false;
    bf16_t* ACT; int ldc;
    __device__ __forceinline__ void operator()(const f32x4 (&acc)[2][2][4][2], const Unit& u, int wr, int wc, int fr, int fq) const {
        const int row0 = u.pm * BM + wr * 64 + fr, c0 = u.pn * HALF + wc * 32 + 8 * fq;
#pragma unroll
        for (int ai = 0; ai < 2; ++ai)
#pragma unroll
            for (int m = 0; m < 4; ++m) { bf16_t* rowp = ACT + (size_t)(row0 + ai * HALF + m * 16) * ldc + c0;
                const f32x4 g0 = acc[ai][0][m][0], g1 = acc[ai][0][m][1], u0 = acc[ai][1][m][0], u1 = acc[ai][1][m][1];
                u32x4 w; w.x = pk2(silu(g0[0]) * u0[0], silu(g0[1]) * u0[1]); w.y = pk2(silu(g0[2]) * u0[2], silu(g0[3]) * u0[3]);
                w.z = pk2(silu(g1[0]) * u1[0], silu(g1[1]) * u1[1]); w.w = pk2(silu(g1[2]) * u1[2], silu(g1[3]) * u1[3]);
                *(u32x4*)rowp = w; }
    }
};
struct EpiSwigluF8b {
    static constexpr bool PERM = true; static constexpr bool AFTER_DRAIN = false; static constexpr bool F8 = true;
    bf16_t* ACT; int ldc;
    __device__ __forceinline__ void operator()(const f32x4 (&acc)[2][2][4][2], const Unit& u, int wr, int wc, int fr, int fq) const {
        const int row0 = u.pm * BM + wr * 64 + fr, c0 = u.pn * HALF + wc * 32 + 8 * fq;
#pragma unroll
        for (int ai = 0; ai < 2; ++ai)
#pragma unroll
            for (int m = 0; m < 4; ++m) { bf16_t* rowp = ACT + (size_t)(row0 + ai * HALF + m * 16) * ldc + c0;
                const f32x4 g0 = acc[ai][0][m][0], g1 = acc[ai][0][m][1], u0 = acc[ai][1][m][0], u1 = acc[ai][1][m][1];
                u32x4 w; w.x = pk2(silu(g0[0]) * u0[0], silu(g0[1]) * u0[1]); w.y = pk2(silu(g0[2]) * u0[2], silu(g0[3]) * u0[3]);
                w.z = pk2(silu(g1[0]) * u1[0], silu(g1[1]) * u1[1]); w.w = pk2(silu(g1[2]) * u1[2], silu(g1[3]) * u1[3]);
                *(u32x4*)rowp = w; }
    }
};
struct EpiSwigluF8 {
    static constexpr bool PERM = true; static constexpr bool AFTER_DRAIN = false; static constexpr bool F8 = true;
    bf16_t* ACT; int ldc;
    __device__ __forceinline__ void operator()(const f32x4 (&acc)[2][2][4][2], const Unit& u, int wr, int wc, int fr, int fq) const {
        const int row0 = u.pm * BM + wr * 64 + fr, c0 = u.pn * HALF + wc * 32 + 8 * fq;
#pragma unroll
        for (int ai = 0; ai < 2; ++ai)
#pragma unroll
            for (int m = 0; m < 4; ++m) { unsigned char* rowp = (unsigned char*)ACT + (size_t)(row0 + ai * HALF + m * 16) * ldc + c0;
                const f32x4 g0 = acc[ai][0][m][0], g1 = acc[ai][0][m][1], u0 = acc[ai][1][m][0], u1 = acc[ai][1][m][1];
                const float o0 = silu(g0[0]) * u0[0], o1 = silu(g0[1]) * u0[1], o2 = silu(g0[2]) * u0[2], o3 = silu(g0[3]) * u0[3], o4 = silu(g1[0]) * u1[0], o5 = silu(g1[1]) * u1[1], o6 = silu(g1[2]) * u1[2], o7 = silu(g1[3]) * u1[3];
                u32x2 w; w.x = pk8x4(o0, o1, o2, o3); w.y = pk8x4(o4, o5, o6, o7);
                *(u32x2*)rowp = w; }
    }
};
template <bool F8V> struct EpiFuseT {
    static constexpr bool PERM = true; static constexpr bool AFTER_DRAIN = true; static constexpr bool F8 = F8V;
    const bf16_t* xs; bf16_t* xd; bf16_t* H; const float* mf; const float* gpost; const float* gpre; int lpost, lpre, gate_off, sc_off, sh_off;
    f32x4* slots; unsigned* cnt; unsigned* tmo; int h8; unsigned char* H8x;
    __device__ __forceinline__ void operator()(const f32x4 (&)[2][2][4][2], const Unit&, int, int, int, int) const {}
    __device__ __forceinline__ void fused(f32x4 (&acc)[2][2][4][2], const Unit& u, int wr, int wc, int fr, int fq, LAS unsigned char* lds) const {
        const int tid = ltid(); const int b = u.pm >> 4, c0 = u.pn * BM + wc * 32 + 8 * fq;
        LAS f32x4* P = (LAS f32x4*)lds;
        LAS float* RR = (LAS float*)(lds + 16384);
        f32x4* sp = slots + (size_t)u.pm * 1024;
        { f32x4 Gv[2][2]; const float* mg = mf + (size_t)(lpost * 4 + b) * 6144 + gate_off;
#pragma unroll
          for (int bj = 0; bj < 2; ++bj)
#pragma unroll
              for (int n = 0; n < 2; ++n) Gv[bj][n] = *(const f32x4*)(mg + c0 + bj * HALF + n * 4) * *(const f32x4*)(gpost + c0 + bj * HALF + n * 4);
#pragma unroll
          for (int ai = 0; ai < 2; ++ai)
#pragma unroll
              for (int m = 0; m < 4; ++m) { const int rloc = wr * 64 + fr + ai * HALF + m * 16; const size_t row = (size_t)u.pm * BM + rloc;
                  float s0 = 0.f, s1 = 0.f, s2 = 0.f, s3 = 0.f;
#pragma unroll
                  for (int bj = 0; bj < 2; ++bj) { const u32x4 xv = *(const u32x4*)(xs + row * 1024 + c0 + bj * HALF);
                      const float xf[8] = {bflo(xv.x), bfhi(xv.x), bflo(xv.y), bfhi(xv.y), bflo(xv.z), bfhi(xv.z), bflo(xv.w), bfhi(xv.w)};
#pragma unroll
                      for (int n = 0; n < 2; ++n)
#pragma unroll
                          for (int q = 0; q < 4; ++q) { const float y = acc[ai][bj][m][n][q], gy = Gv[bj][n][q] * y, x = xf[n * 4 + q]; acc[ai][bj][m][n][q] = gy;
                              s0 += y * y; s1 += x * x; s2 += x * gy; s3 += gy * gy; } }
                  s0 += __shfl_xor(s0, 16); s1 += __shfl_xor(s1, 16); s2 += __shfl_xor(s2, 16); s3 += __shfl_xor(s3, 16);
                  s0 += __shfl_xor(s0, 32); s1 += __shfl_xor(s1, 32); s2 += __shfl_xor(s2, 32); s3 += __shfl_xor(s3, 32);
                  if (fq == 0) P[wc * 256 + rloc] = (f32x4){s0, s1, s2, s3}; } }
        __syncthreads();
        if (tid < 256) { const f32x4 S = (P[tid] + P[256 + tid]) + (P[512 + tid] + P[768 + tid]);
            asm volatile("global_store_dwordx4 %0, %1, off sc1\n\ts_nop 1" :: "v"(sp + u.pn * 256 + tid), "v"(S) : "memory"); }
        asm volatile("s_waitcnt vmcnt(0)" ::: "memory");
        __syncthreads();
        if (tid == 0) { unsigned* w = cnt + u.pm; __hip_atomic_fetch_add(w, 1u, __ATOMIC_RELAXED, __HIP_MEMORY_SCOPE_AGENT); unsigned spn = 0;
            while (__hip_atomic_load(w, __ATOMIC_RELAXED, __HIP_MEMORY_SCOPE_AGENT) < 4u) { __builtin_amdgcn_s_sleep(2);
                if ((++spn & 255u) == 0u) { if (__hip_atomic_load(tmo, __ATOMIC_RELAXED, __HIP_MEMORY_SCOPE_AGENT) != 0u) break; if (spn > (1u << 22)) { __hip_atomic_store(tmo, 1u, __ATOMIC_RELAXED, __HIP_MEMORY_SCOPE_AGENT); break; } } }
            __builtin_amdgcn_fence(__ATOMIC_ACQUIRE, "agent"); asm volatile("s_waitcnt vmcnt(0)" ::: "memory"); }
        __syncthreads();
        if (tid < 256) { const f32x4 T = (sp[tid] + sp[256 + tid]) + (sp[512 + tid] + sp[768 + tid]);
            const float r = 1.0f / sqrtf(T[0] * (1.f / 1024.f) + EPS); const float ssm = T[1] + 2.f * r * T[2] + r * r * T[3];
            RR[tid * 2] = r; RR[tid * 2 + 1] = 1.0f / sqrtf(fmaxf(ssm, 0.f) * (1.f / 1024.f) + EPS); }
        __syncthreads();
        { f32x4 Av[2][2], Bv[2][2]; const float* ms = mf + (size_t)(lpre * 4 + b) * 6144;
#pragma unroll
          for (int bj = 0; bj < 2; ++bj)
#pragma unroll
              for (int n = 0; n < 2; ++n) { const int c = c0 + bj * HALF + n * 4; Av[bj][n] = *(const f32x4*)(gpre + c) * (*(const f32x4*)(ms + sc_off + c) + 1.f); Bv[bj][n] = *(const f32x4*)(ms + sh_off + c); }
#pragma unroll
          for (int ai = 0; ai < 2; ++ai)
#pragma unroll
              for (int m = 0; m < 4; ++m) { const int rloc = wr * 64 + fr + ai * HALF + m * 16; const size_t row = (size_t)u.pm * BM + rloc; const float r = RR[rloc * 2], r2 = RR[rloc * 2 + 1];
#pragma unroll
                  for (int bj = 0; bj < 2; ++bj) { const u32x4 xv = *(const u32x4*)(xs + row * 1024 + c0 + bj * HALF);
                      const float xf[8] = {bflo(xv.x), bfhi(xv.x), bflo(xv.y), bfhi(xv.y), bflo(xv.z), bfhi(xv.z), bflo(xv.w), bfhi(xv.w)};
                      float xm[8], hv[8];
#pragma unroll
                      for (int n = 0; n < 2; ++n)
#pragma unroll
                          for (int q = 0; q < 4; ++q) { xm[n * 4 + q] = xf[n * 4 + q] + r * acc[ai][bj][m][n][q]; hv[n * 4 + q] = (xm[n * 4 + q] * r2) * Av[bj][n][q] + Bv[bj][n][q]; }
                      u32x4 wx, wh; wx.x = pk2(xm[0], xm[1]); wx.y = pk2(xm[2], xm[3]); wx.z = pk2(xm[4], xm[5]); wx.w = pk2(xm[6], xm[7]);
                      wh.x = pk2(hv[0], hv[1]); wh.y = pk2(hv[2], hv[3]); wh.z = pk2(hv[4], hv[5]); wh.w = pk2(hv[6], hv[7]);
                      *(u32x4*)(xd + row * 1024 + c0 + bj * HALF) = wx;
                      if (h8) { u32x2 w8; w8.x = pk8x4(hv[0], hv[1], hv[2], hv[3]);
                          w8.y = pk8x4(hv[4], hv[5], hv[6], hv[7]);
                          *(u32x2*)((unsigned char*)H + row * 1024 + c0 + bj * HALF) = w8; }
                      else { *(u32x4*)(H + row * 1024 + c0 + bj * HALF) = wh;
                          if (H8x) { u32x2 w8; w8.x = pk8x4(hv[0], hv[1], hv[2], hv[3]); w8.y = pk8x4(hv[4], hv[5], hv[6], hv[7]); *(u32x2*)(H8x + row * 1024 + c0 + bj * HALF) = w8; } } } } }
        __syncthreads();
    }
};
typedef EpiFuseT<false> EpiFuse;

typedef int v8i32 __attribute__((ext_vector_type(8)));
__device__ __forceinline__ v8i32 cat32(bf16x8 lo, bf16x8 hi) { typedef int v4i __attribute__((ext_vector_type(4))); const v4i a = __builtin_bit_cast(v4i, lo), b = __builtin_bit_cast(v4i, hi); return (v8i32){a[0], a[1], a[2], a[3], b[0], b[1], b[2], b[3]}; }
__device__ __forceinline__ void mfma_f8(f32x4& c, v8i32 a, v8i32 b, int sc) { asm volatile("v_mfma_scale_f32_16x16x128_f8f6f4 %0, %1, %2, %0, %3, %3 op_sel:[0,1,0] op_sel_hi:[0,0,0]" : "+v"(c) : "v"(a), "v"(b), "v"(sc)); }
template <class Epi, class Sched>
__device__ __forceinline__ void gemm_phase(LAS unsigned char* lds, const int K, const int lda, const int ldb, const Sched& S, const Epi& E) {
    const int tid = ltid(), wid = __builtin_amdgcn_readfirstlane(tid >> 6), lane = tid & 63, wr = wid >> 2, wc = wid & 3, fr = lane & 15, fq = lane >> 4;
    constexpr bool F8 = Epi::F8;
    constexpr int EB = F8 ? 1 : 2;
    int f8one = 0x7f7f7f79; asm volatile("" : "+v"(f8one)); (void)f8one;
    const int nt = K / (F8 ? 2 * BK : BK);
    unsigned voffA[2], voffB[2];
#pragma unroll
    for (int i = 0; i < 2; ++i) { int R, C; stage_rc(tid * 16 + i * 8192, R, C); const int Rb = Epi::PERM ? ((R & ~31) + perm32(R & 31)) : R;
        voffA[i] = Sched::GATHER ? (unsigned)C * 2u : (unsigned)(R * lda * EB + C * 2); voffB[i] = (unsigned)(Rb * ldb * EB + C * 2); }
    const size_t kstep = (size_t)(BK * 2);
    const size_t hstepA = Sched::GATHER ? 0 : (size_t)HALF * lda * EB, hstepB = (size_t)HALF * ldb * EB;
    const unsigned ldsw = (unsigned)wid * 1024u;
    const int aoff = lds_byte(wr * 64 + fr, F8 ? fq * 16 : fq * 8), boff = lds_byte(wc * 32 + fr, F8 ? fq * 16 : fq * 8);
    constexpr int KOFF = F8 ? 16 : 1024;
    unsigned tkC[2] = {0u, 0u}, tkN[2] = {0u, 0u};
#define PG8_SA(b, h) (((b) * 2 + (h)) * HTB)
#define PG8_SB(b, h) ((4 + (b) * 2 + (h)) * HTB)
#define PG8_STAGE(bufoff, gbase, voff) do { _Pragma("unroll") for (int _i = 0; _i < 2; ++_i) \
        __builtin_amdgcn_global_load_lds((const unsigned*)((const char*)(gbase) + (voff)[_i]), (LAS unsigned*)(lds + (bufoff) + ldsw + _i * 8192), 16, 0, 0); } while (0)
#define PG8_STAGE_A(bufoff, p, h, nx) do { if constexpr (Sched::GATHER) { const unsigned _t = (nx) ? tkN[h] : tkC[h]; unsigned _v[2]; _v[0] = ((_t & 0xffffu) << (F8 ? 10 : 11)) + voffA[0]; _v[1] = ((_t >> 16) << (F8 ? 10 : 11)) + voffA[1]; PG8_STAGE(bufoff, p, _v); } \
        else { PG8_STAGE(bufoff, (p) + (h) * hstepA, voffA); } } while (0)
#define PG8_LDA(dst, b, h) do { _Pragma("unroll") for (int m = 0; m < 4; ++m) _Pragma("unroll") for (int k = 0; k < 2; ++k) dst[m][k] = *(const LAS bf16x8*)(lds + PG8_SA(b, h) + aoff + m * 2048 + k * KOFF); } while (0)
#define PG8_LDB(dst, b, h) do { _Pragma("unroll") for (int n = 0; n < 2; ++n) _Pragma("unroll") for (int k = 0; k < 2; ++k) dst[n][k] = *(const LAS bf16x8*)(lds + PG8_SB(b, h) + boff + n * 2048 + k * KOFF); } while (0)
#define PG8_MMA(ai, bj, At, Bt) do { __builtin_amdgcn_s_setprio(1); \
        if constexpr (F8) { _Pragma("unroll") for (int m = 0; m < 4; ++m) _Pragma("unroll") for (int n = 0; n < 2; ++n) \
            mfma_f8(acc[ai][bj][m][n], cat32(Bt[n][0], Bt[n][1]), cat32(At[m][0], At[m][1]), f8one); } \
        else { _Pragma("unroll") for (int m = 0; m < 4; ++m) _Pragma("unroll") for (int n = 0; n < 2; ++n) _Pragma("unroll") for (int k = 0; k < 2; ++k) \
            acc[ai][bj][m][n] = __builtin_amdgcn_mfma_f32_16x16x32_bf16(Bt[n][k], At[m][k], acc[ai][bj][m][n], 0, 0, 0); } __builtin_amdgcn_s_setprio(0); } while (0)
#define PG8_WAIT_V(n) asm volatile("s_waitcnt vmcnt(" #n ")" ::: "memory")
#define PG8_WAIT_L(n) asm volatile("s_waitcnt lgkmcnt(" #n ")" ::: "memory")
#define PG8_BAR __builtin_amdgcn_s_barrier()
#define PG8_SCHED __builtin_amdgcn_sched_barrier(0)
#define PG8_GV(dst, u) do { if constexpr (Sched::GATHER) { const int _t2 = ltid(); int _R0, _R1, _C; stage_rc(_t2 * 16, _R0, _C); stage_rc(_t2 * 16 + 8192, _R1, _C); \
        _Pragma("unroll") for (int _h = 0; _h < 2; ++_h) dst[_h] = S.row_tok(u, _h * HALF + _R0) | (S.row_tok(u, _h * HALF + _R1) << 16); } } while (0)
    Unit cur, nxt; int ui = 0;
    if (!S.next(0, cur)) return;
    f32x4 acc[2][2][4][2];
#pragma unroll
    for (int a = 0; a < 2; ++a)
#pragma unroll
        for (int b = 0; b < 2; ++b)
#pragma unroll
            for (int m = 0; m < 4; ++m)
#pragma unroll
                for (int n = 0; n < 2; ++n) acc[a][b][m][n] = (f32x4){0.f, 0.f, 0.f, 0.f};
    bf16x8 At[4][2], B0[2][2], B1[2][2];
    const char* cA = S.a_ptr(cur); const char* cB = S.b_ptr(cur);
    PG8_GV(tkC, cur);
    tkN[0] = tkC[0]; tkN[1] = tkC[1];
    PG8_STAGE(PG8_SB(0, 0), cB, voffB); PG8_STAGE(PG8_SB(0, 1), cB + hstepB, voffB); PG8_STAGE_A(PG8_SA(0, 0), cA, 0, false); PG8_STAGE_A(PG8_SA(0, 1), cA, 1, false);
    if (wr == 1) PG8_BAR;
    PG8_WAIT_V(2); PG8_BAR;
    PG8_STAGE(PG8_SB(1, 0), cB + kstep, voffB); PG8_STAGE_A(PG8_SA(1, 0), cA + kstep, 0, false); PG8_STAGE(PG8_SB(1, 1), cB + hstepB + kstep, voffB);
    PG8_WAIT_V(6); PG8_BAR;
    for (;;) {
        const bool has_next = S.next(ui + 1, nxt);
        const char* nA = has_next ? S.a_ptr(nxt) : cA; const char* nB = has_next ? S.b_ptr(nxt) : cB;
        for (int t = 0; t < nt; t += 2) {
            const bool last = (t == nt - 2);
            if constexpr (Sched::GATHER) { if (t == nt - 4 && has_next) PG8_GV(tkN, nxt); }
            const char* a1 = cA + (size_t)(t + 1) * kstep;
            const char* a2 = last ? nA : cA + (size_t)(t + 2) * kstep; const char* b2 = last ? nB : cB + (size_t)(t + 2) * kstep;
            const char* a3 = a2 + kstep; const char* b3 = b2 + kstep;
            const bool nx = last && has_next;
            PG8_LDB(B0, 0, 0); PG8_LDB(B1, 0, 1); PG8_SCHED; PG8_LDA(At, 0, 0); PG8_STAGE_A(PG8_SA(1, 1), a1, 1, false);
            PG8_WAIT_V(8); PG8_WAIT_L(0); PG8_BAR; PG8_MMA(0, 0, At, B0); PG8_MMA(0, 1, At, B1); PG8_BAR; PG8_SCHED;
            PG8_LDA(At, 0, 1); PG8_STAGE(PG8_SB(0, 0), b2, voffB); PG8_STAGE(PG8_SB(0, 1), b2 + hstepB, voffB); PG8_STAGE_A(PG8_SA(0, 0), a2, 0, nx);
            PG8_WAIT_V(8); PG8_WAIT_L(0); PG8_BAR; PG8_MMA(1, 0, At, B0); PG8_MMA(1, 1, At, B1); PG8_BAR; PG8_SCHED;
            PG8_LDB(B0, 1, 0); PG8_LDB(B1, 1, 1); PG8_SCHED; PG8_LDA(At, 1, 0); PG8_STAGE_A(PG8_SA(0, 1), a2, 1, nx);
            PG8_WAIT_V(8); PG8_WAIT_L(0); PG8_BAR; PG8_MMA(0, 0, At, B0); PG8_MMA(0, 1, At, B1); PG8_BAR; PG8_SCHED;
            PG8_LDA(At, 1, 1); PG8_STAGE(PG8_SB(1, 0), b3, voffB); PG8_STAGE(PG8_SB(1, 1), b3 + hstepB, voffB); PG8_STAGE_A(PG8_SA(1, 0), a3, 0, nx);
            PG8_WAIT_V(8); PG8_WAIT_L(0); PG8_BAR; PG8_MMA(1, 0, At, B0); PG8_MMA(1, 1, At, B1); PG8_BAR; PG8_SCHED;
        }
        if (wr == 0) PG8_BAR;
        if constexpr (F8) asm volatile("s_nop 15\n\ts_nop 7" ::: "memory");
        if constexpr (!Epi::AFTER_DRAIN) E(acc, cur, wr, wc, fr, fq);
        if (!has_next) break;
#pragma unroll
        for (int a = 0; a < 2; ++a)
#pragma unroll
            for (int b = 0; b < 2; ++b)
#pragma unroll
                for (int m = 0; m < 4; ++m)
#pragma unroll
                    for (int n = 0; n < 2; ++n) acc[a][b][m][n] = (f32x4){0.f, 0.f, 0.f, 0.f};
        cur = nxt; cA = nA; cB = nB; ++ui;
        tkC[0] = tkN[0]; tkC[1] = tkN[1];
        if (wr == 1) PG8_BAR;
    }
    PG8_WAIT_V(0);
    PG8_BAR;
    if constexpr (Epi::AFTER_DRAIN) E.fused(acc, cur, wr, wc, fr, fq, lds);
#undef PG8_SA
#undef PG8_SB
#undef PG8_STAGE
#undef PG8_STAGE_A
#undef PG8_LDA
#undef PG8_LDB
#undef PG8_MMA
#undef PG8_WAIT_V
#undef PG8_WAIT_L
#undef PG8_BAR
#undef PG8_SCHED
#undef PG8_GV
}
}
struct Args { const float* in[27]; float* out; unsigned char* ws; int ph_lo, ph_hi, dbg, pad; };
#define CAS __attribute__((address_space(4)))
typedef const CAS Args* ArgsP;
enum { I_X = 0, I_C, I_ADAW, I_ADAB, I_MPREG, I_MPOSTG, I_FPREG, I_FPOSTG, I_WIN, I_GA2, I_GAB, I_CDW, I_CDWB, I_CLNG, I_CLNB, I_GNG, I_WCO, I_WSO, I_WGO, I_WO,
       I_FWG, I_FWU, I_FWD, I_RW, I_MWG, I_MWU, I_MWD };

struct TrItem { const float* src; size_t stride; bf16_t* dst; int dstK; float scale; int f8; };
constexpr int TRK = 256;
constexpr int IT_WIN = 4 * 124 * 4, IT_WCAT = 4 * 16 * 6, IT_WO = 4 * 16 * 4, IT_WGU = 2 * 88 * 4, IT_WDN = 2 * 16 * 11, IT_WMGU = 16 * 112 * 4, IT_WMDN = 16 * 16 * 14, IT_MOD = 4 * 12 * 8;
constexpr int IT_TR = IT_WIN + IT_WCAT + IT_WO + IT_WGU + IT_WDN + IT_WMGU + IT_WMDN, IT_TOTAL = IT_TR + IT_MOD;
__device__ __forceinline__ TrItem tr_item(ArgsP a, int it, int nl) {
    unsigned char* ws = a->ws; TrItem r; r.scale = 1.f; r.f8 = 0;
    if (it < IT_WIN) { const int l = it / 496, q = it % 496, nt = q % 124, kt = q / 124; const int n = nt * 64 + nl;
        int col; if (n < 1024) col = ((nt & 2) ? 512 : 0) + (nt >> 2) * 128 + (nt & 1) * 64 + nl;        else if (n < 4608) col = n; else if (n < 7680) col = n + 16; else if (n < 7696) col = 4608 + (n - 7680); else col = -1;
        r.src = col >= 0 ? a->in[I_WIN] + (size_t)l * 1024 * IN_SRC + (size_t)(kt * TRK) * IN_SRC + col : nullptr; r.stride = IN_SRC;
        r.dst = (bf16_t*)(ws + WS_WIN) + ((size_t)l * NIN + nt * 64) * 1024 + kt * TRK; r.dstK = 1024;
        r.scale = (nt >> 3) == 2 ? 0.125f * LOG2E : (nt >> 3) == 5 ? 0.08838834764831845f : 1.f;
        if (l >= 2) { r.dst = (bf16_t*)(ws + WS_WIN + (size_t)l * NIN * 1024 * 2 + ((size_t)nt * 64) * 1024 + kt * TRK); r.f8 = 1; r.scale *= 64.f; }
        else if (nt >= 72 && nt < 120) { r.dst = (bf16_t*)(ws + WS_WIN + (size_t)l * NIN * 1024 * 2 + (size_t)4608 * 2048 + ((size_t)(nt * 64 - 4608)) * 1024 + kt * TRK); r.f8 = 1; r.scale *= 64.f; }
        return r; }
    it -= IT_WIN;
    if (it < IT_WCAT) { const int l = it / 96, q = it % 96, nt = q % 16, kt = q / 16, which = kt >> 1, ks = (kt & 1) * TRK; const int n = nt * 64 + nl;
        const float* W = which == 0 ? a->in[I_WCO] : which == 1 ? a->in[I_WSO] : a->in[I_WGO];
        r.src = W + (size_t)l * 512 * 1024 + (size_t)ks * 1024 + n; r.stride = 1024; r.dst = (bf16_t*)(ws + WS_WCAT) + ((size_t)l * 1024 + nt * 64) * 1536 + kt * TRK; r.dstK = 1536; return r; }
    it -= IT_WCAT;
    if (it < IT_WO) { const int l = it / 64, q = it % 64, nt = q % 16, kt = q / 16; const int n = nt * 64 + nl;
        r.src = a->in[I_WO] + (size_t)l * 1024 * 1024 + (size_t)(kt * TRK) * 1024 + n; r.stride = 1024; r.dst = (bf16_t*)(ws + WS_WO) + ((size_t)l * 1024 + nt * 64) * 1024 + kt * TRK; r.dstK = 1024; return r; }
    it -= IT_WO;
    if (it < IT_WGU) { const int j = it / 352, q = it % 352, nt = q % 88, kt = q / 88; const int n = nt * 64 + nl;
        const float* W = (nt & 2) ? a->in[I_FWU] : a->in[I_FWG];
        r.src = W + (size_t)j * 1024 * DFF + (size_t)(kt * TRK) * DFF + ((nt >> 2) * 128 + (nt & 1) * 64 + nl); (void)n; r.stride = DFF; r.dst = (bf16_t*)(ws + WS_WGU) + ((size_t)j * 5632 + nt * 64) * 1024 + kt * TRK; r.dstK = 1024;
        if (j == 1) { r.dst = (bf16_t*)(ws + WS_WGU + (size_t)5632 * 1024 * 2 + ((size_t)nt * 64) * 1024 + kt * TRK); r.f8 = 1; r.scale = 64.f; }
        return r; }
    it -= IT_WGU;
    if (it < IT_WDN) { const int j = it / 176, q = it % 176, nt = q % 16, kt = q / 16; const int n = nt * 64 + nl;
        r.src = a->in[I_FWD] + (size_t)j * DFF * 1024 + (size_t)(kt * TRK) * 1024 + n; r.stride = 1024; r.dst = (bf16_t*)(ws + WS_WDN) + ((size_t)j * 1024 + nt * 64) * DFF + kt * TRK; r.dstK = DFF;
        if (j == 1) { r.dst = (bf16_t*)(ws + WS_WDN + (size_t)1024 * DFF * 2 + ((size_t)nt * 64) * DFF + kt * TRK); r.f8 = 1; r.scale = 64.f; }
        return r; }
    it -= IT_WDN;
    if (it < IT_WMGU) { const int je = it / 448, q = it % 448, nt = q % 112, kt = q / 112; const int n = nt * 64 + nl;
        const float* W = (nt & 2) ? a->in[I_MWU] : a->in[I_MWG];
        r.src = W + (size_t)je * 1024 * DFFE + (size_t)(kt * TRK) * DFFE + ((nt >> 2) * 128 + (nt & 1) * 64 + nl); (void)n; r.stride = DFFE;
        r.dst = (bf16_t*)(ws + WS_WMGU + ((size_t)je * 7168 + nt * 64) * 1024 + kt * TRK); r.dstK = 1024; r.f8 = 1; r.scale = 64.f; return r; }
    it -= IT_WMGU;
    { const int je = it / 224, q = it % 224, nt = q % 16, kt = q / 16; const int n = nt * 64 + nl;
        r.src = a->in[I_MWD] + (size_t)je * DFFE * 1024 + (size_t)(kt * TRK) * 1024 + n; r.stride = 1024; r.dst = (bf16_t*)(ws + WS_WMDN + ((size_t)je * 1024 + nt * 64) * DFFE + kt * TRK); r.dstK = DFFE; r.f8 = 1; r.scale = 64.f; return r; }
}
#define P0_BARRIER() do { asm volatile("s_waitcnt lgkmcnt(0)" ::: "memory"); __builtin_amdgcn_s_barrier(); asm volatile("" ::: "memory"); } while (0)
__device__ __forceinline__ void p0_prologue(LAS unsigned char* lds, ArgsP a) {
    LAS float* T = (LAS float*)lds;
    unsigned char* ws = a->ws; const int tid = ltid(), nl = tid & 63, kq = tid >> 6;
    const int G = lgrid();
    int it = lbid(); float v[32];
    TrItem cur{};
    if (it < IT_TR) { cur = tr_item(a, it, nl); const float* sp = cur.src ? cur.src : a->in[I_ADAB]; const size_t st = cur.src ? cur.stride : 0;
#pragma unroll
        for (int kk = 0; kk < 32; ++kk) v[kk] = sp[(size_t)(kq + 8 * kk) * st]; }
    bool zero = (cur.src == nullptr);
    while (it < IT_TR) {
#pragma unroll
        for (int kk = 0; kk < 32; ++kk) T[nl * 257 + kq + 8 * kk] = zero ? 0.f : v[kk] * cur.scale;
        const int nit = it + G; bf16_t* dst = cur.dst; const int dstK = cur.dstK, f8 = cur.f8;
        if (nit < IT_TR) { cur = tr_item(a, nit, nl); const float* sp = cur.src ? cur.src : a->in[I_ADAB]; const size_t st = cur.src ? cur.stride : 0; zero = (cur.src == nullptr);
#pragma unroll
            for (int kk = 0; kk < 32; ++kk) v[kk] = sp[(size_t)(kq + 8 * kk) * st]; }
        P0_BARRIER();
        if (f8) { const int n2 = tid >> 3, ch = tid & 7; unsigned char* d8 = (unsigned char*)dst;
#pragma unroll
          for (int q2 = 0; q2 < 2; ++q2) { const LAS float* s = T + n2 * 257 + 16 * (ch + 8 * q2); u32x4 o;
              o.x = pk8x4(s[0], s[1], s[2], s[3]);
              o.y = pk8x4(s[4], s[5], s[6], s[7]);
              o.z = pk8x4(s[8], s[9], s[10], s[11]);
              o.w = pk8x4(s[12], s[13], s[14], s[15]);
              *(u32x4*)(d8 + (size_t)n2 * dstK + 16 * (ch + 8 * q2)) = o; } }
        else { const int n2 = tid >> 3, ch = tid & 7;
#pragma unroll
          for (int q4 = 0; q4 < 4; ++q4) { const LAS float* s = T + n2 * 257 + 8 * (ch + 8 * q4);
              u32x4 o; o.x = pk2(s[0], s[1]); o.y = pk2(s[2], s[3]); o.z = pk2(s[4], s[5]); o.w = pk2(s[6], s[7]);
              *(u32x4*)(dst + (size_t)n2 * dstK + 8 * (ch + 8 * q4)) = o; } }
        P0_BARRIER();
        it = nit;
    }
    __syncthreads();
    for (it -= IT_TR; it < IT_MOD; it += G) {
        const int l = it / 96, r = it % 96, cg = r % 12, ks = r / 12; const int n = cg * 512 + tid;
        LAS float* CD = T;
        { const int b = tid >> 7, k = tid & 127; CD[tid] = silu(a->in[I_C][b * 1024 + ks * 128 + k]); }
        __syncthreads();
        const float* W = a->in[I_ADAW] + (size_t)l * 1024 * 6144 + (size_t)(ks * 128) * 6144 + n;
        float s0 = 0.f, s1 = 0.f, s2 = 0.f, s3 = 0.f;
#pragma unroll 8
        for (int k = 0; k < 128; ++k) { const float w = W[(size_t)k * 6144]; s0 += CD[k] * w; s1 += CD[128 + k] * w; s2 += CD[256 + k] * w; s3 += CD[384 + k] * w; }
        float* P = (float*)(ws + WS_MODP) + (size_t)ks * 98304 + (size_t)l * 4 * 6144 + n;
        P[0] = s0; P[6144] = s1; P[2 * 6144] = s2; P[3 * 6144] = s3;
        __syncthreads();
    }
}

struct ThinP {
    const float* xsrc; float* xdst;
    const bf16_t* xsrcb; bf16_t* xdstb;
    int post;
    const bf16_t* y; const bf16_t* oe; const float* gpost; int lpost, gate_off;
    int pre; const float* gpre; int lpre, sh_off, sc_off; bf16_t* H; unsigned char* H8;
    int route; const float* rw; unsigned* cnt;
    int from_partials;
};
__device__ __forceinline__ float mod_val(ArgsP a, int from_partials, int l, int b, int j) {
    const size_t idx = (size_t)(l * 4 + b) * 6144 + j;
    if (from_partials) { const float* P = (const float*)(a->ws + WS_MODP) + idx; float s = a->in[I_ADAB][l * 6144 + j];
#pragma unroll
        for (int ks = 0; ks < 8; ++ks) s += P[(size_t)ks * 98304];
        return s; }
    return ((const float*)(a->ws + WS_MODF))[idx];
}
__device__ __forceinline__ void moe_table(LAS int* tab, const unsigned* wcnt) {
    const int tid = ltid(); LAS int* B = (LAS int*)((LAS unsigned char*)tab + (BASE_OFF - TAB_OFF)); LAS int* GS = (LAS int*)((LAS unsigned char*)tab + (GSUM_OFF - TAB_OFF));
    __syncthreads();
    if (tid < 64) { const int e = tid & 7, g = tid >> 3; int cv[32];
#pragma unroll
        for (int k = 0; k < 32; ++k) cv[k] = (int)wcnt[(g * 32 + k) * 8 + e];
        int run = 0;
#pragma unroll
        for (int k = 0; k < 32; ++k) { B[e * 257 + g * 32 + k] = run; run += cv[k]; }
        GS[g * 8 + e] = run; }
    __syncthreads();
    if (tid < 64) { const int e = tid & 7, g = tid >> 3; int off = 0;
        for (int g2 = 0; g2 < g; ++g2) off += GS[g2 * 8 + e];
        for (int k = 0; k < 32; ++k) B[e * 257 + g * 32 + k] += off;
        if (g == 7) B[e * 257 + 256] = off + GS[56 + e]; }
    __syncthreads();
    if (tid == 0) { int pre = 0;
        for (int e = 0; e < 8; ++e) { const int c = B[e * 257 + 256]; tab[e] = pre; tab[16 + e] = c; pre += (c + 255) >> 8; }
        tab[8] = pre; }
    __syncthreads();
}
template <bool SRCB>
__device__ __forceinline__ void thin_phase(LAS unsigned char* lds, ArgsP a, const ThinP& P) {
    const int tid = ltid(), lane = tid & 63, wid = __builtin_amdgcn_readfirstlane(tid >> 6);
    LAS float* VG = (LAS float*)lds; LAS float* VA = VG + 1024; LAS float* VB = VG + 2048;
    LAS float* RW = (LAS float*)(lds + 12288);
    LAS int* LC = (LAS int*)(lds + 45056);
    LAS int* REC = (LAS int*)(lds + 45056 + 512);
    LAS int* tab = (LAS int*)(lds + TAB_OFF);
    if (P.from_partials) {
        float* MF = (float*)(a->ws + WS_MODF);
        for (int idx = lbid() * 512 + tid; idx < 98304; idx += lgrid() * 512) { const int l = idx / 24576, r = idx % 24576, b = r / 6144, j = r % 6144; MF[idx] = mod_val(a, 1, l, b, j); }
    }
    if (P.post == 2) moe_table(tab, P.cnt);
    for (int rb = lbid(); rb < MTOK / 64; rb += lgrid()) {
        const int b = rb >> 6;
        __syncthreads();
        for (int c = tid; c < 1024; c += 512) {
            if (P.post) VG[c] = mod_val(a, P.from_partials, P.lpost, b, P.gate_off + c) * P.gpost[c];
            if (P.pre) { VA[c] = P.gpre[c] * (1.f + mod_val(a, P.from_partials, P.lpre, b, P.sc_off + c)); VB[c] = mod_val(a, P.from_partials, P.lpre, b, P.sh_off + c); }
        }
        if (P.route) { for (int i = tid; i < 8192; i += 512) RW[i] = P.rw[i]; if (tid < 64) LC[tid] = 0; }
        __syncthreads();
        f32x4 Gr[4], Ar[4], Br[4];
#pragma unroll
        for (int i = 0; i < 4; ++i) { const int c = 256 * i + 4 * lane; Gr[i] = *(const LAS f32x4*)(VG + c); Ar[i] = *(const LAS f32x4*)(VA + c); Br[i] = *(const LAS f32x4*)(VB + c); }
        constexpr int RB = 4;
        const LAS int* BS = (const LAS int*)((const LAS unsigned char*)tab + (BASE_OFF - TAB_OFF));
        const float* OEX = (const float*)(a->ws + WS_OEX);
#pragma unroll 1
        for (int r0 = 0; r0 < 8; r0 += RB) {
            f32x4 xf[RB][4]; u32x2 xq[RB][4], y1q[RB][4], y2q[RB][4]; float pw1[RB], pw2[RB]; size_t g1[RB], g2[RB];
#pragma unroll
            for (int k = 0; k < RB; ++k) { const size_t row = (size_t)rb * 64 + wid * 8 + r0 + k;
#pragma unroll
                for (int i = 0; i < 4; ++i) { if constexpr (SRCB) xq[k][i] = *(const u32x2*)(P.xsrcb + row * 1024 + 256 * i + 4 * lane); else xf[k][i] = *(const f32x4*)(P.xsrc + row * 1024 + 256 * i + 4 * lane); } }
            if (P.post == 1) {
#pragma unroll
                for (int k = 0; k < RB; ++k) { const size_t row = (size_t)rb * 64 + wid * 8 + r0 + k;
#pragma unroll
                    for (int i = 0; i < 4; ++i) y1q[k][i] = *(const u32x2*)(P.y + row * 1024 + 256 * i + 4 * lane); }
            } else if (P.post == 2) {
                int ee[RB], s1[RB], s2[RB];
#pragma unroll
                for (int k = 0; k < RB; ++k) { const size_t row = (size_t)rb * 64 + wid * 8 + r0 + k;
                    ee[k] = ((const int*)(a->ws + WS_TOKE))[row]; s1[k] = ((const int*)(a->ws + WS_TOKS))[row * 2]; s2[k] = ((const int*)(a->ws + WS_TOKS))[row * 2 + 1];
                    pw1[k] = ((const float*)(a->ws + WS_TOKP))[row * 2]; pw2[k] = ((const float*)(a->ws + WS_TOKP))[row * 2 + 1]; }
#pragma unroll
                for (int k = 0; k < RB; ++k) { const int e1 = ee[k] & 255, e2 = (ee[k] >> 8) & 255;
                    g1[k] = (size_t)tab[e1] * 256 + BS[e1 * 257 + rb] + s1[k]; g2[k] = (size_t)tab[e2] * 256 + BS[e2 * 257 + rb] + s2[k];
#pragma unroll
                    for (int i = 0; i < 4; ++i) { y1q[k][i] = *(const u32x2*)(P.oe + g1[k] * 1024 + 256 * i + 4 * lane); y2q[k][i] = *(const u32x2*)(P.oe + g2[k] * 1024 + 256 * i + 4 * lane); } }
            }
#pragma unroll
            for (int k = 0; k < RB; ++k) {
                const int rl = wid * 8 + r0 + k; const size_t row = (size_t)rb * 64 + rl;
                f32x4 x[4];
#pragma unroll
                for (int i = 0; i < 4; ++i) { if constexpr (SRCB) x[i] = (f32x4){bflo(xq[k][i].x), bfhi(xq[k][i].x), bflo(xq[k][i].y), bfhi(xq[k][i].y)};
                    else { x[i] = xf[k][i]; u32x2 wx; wx.x = pk2(x[i][0], x[i][1]); wx.y = pk2(x[i][2], x[i][3]); *(u32x2*)(P.xdstb + row * 1024 + 256 * i + 4 * lane) = wx; } }
                if (P.post) {
                    f32x4 y[4];
                    if (P.post == 1) {
#pragma unroll
                        for (int i = 0; i < 4; ++i) y[i] = (f32x4){bflo(y1q[k][i].x), bfhi(y1q[k][i].x), bflo(y1q[k][i].y), bfhi(y1q[k][i].y)};
                    } else {
#pragma unroll
                        for (int i = 0; i < 4; ++i) { f32x4 y1, y2;
                            if (g1[k] < 32768) y1 = (f32x4){bflo(y1q[k][i].x), bfhi(y1q[k][i].x), bflo(y1q[k][i].y), bfhi(y1q[k][i].y)};
                            else { const float* q = OEX + (g1[k] - 32768) * 1024 + 256 * i + 4 * lane; y1 = *(const f32x4*)q + *(const f32x4*)(q + 2097152); }
                            if (g2[k] < 32768) y2 = (f32x4){bflo(y2q[k][i].x), bfhi(y2q[k][i].x), bflo(y2q[k][i].y), bfhi(y2q[k][i].y)};
                            else { const float* q = OEX + (g2[k] - 32768) * 1024 + 256 * i + 4 * lane; y2 = *(const f32x4*)q + *(const f32x4*)(q + 2097152); }
                            y[i] = y1 * pw1[k] + y2 * pw2[k]; }
                    }
                    float ss = 0.f;
#pragma unroll
                    for (int i = 0; i < 4; ++i) ss += (y[i][0] * y[i][0] + y[i][1] * y[i][1]) + (y[i][2] * y[i][2] + y[i][3] * y[i][3]);
                    const float rstd = 1.0f / sqrtf(wave_sum(ss) * (1.f / 1024.f) + EPS);
#pragma unroll
                    for (int i = 0; i < 4; ++i) x[i] = x[i] + Gr[i] * (y[i] * rstd);
                    if (P.xdst) {
#pragma unroll
                        for (int i = 0; i < 4; ++i) *(f32x4*)(P.xdst + row * 1024 + 256 * i + 4 * lane) = x[i];
                    } else {
#pragma unroll
                        for (int i = 0; i < 4; ++i) { u32x2 wx; wx.x = pk2(x[i][0], x[i][1]); wx.y = pk2(x[i][2], x[i][3]); *(u32x2*)(P.xdstb + row * 1024 + 256 * i + 4 * lane) = wx; }
                    }
                }
                if (P.pre) {
                    float ss = 0.f;
#pragma unroll
                    for (int i = 0; i < 4; ++i) ss += (x[i][0] * x[i][0] + x[i][1] * x[i][1]) + (x[i][2] * x[i][2] + x[i][3] * x[i][3]);
                    const float rstd = 1.0f / sqrtf(wave_sum(ss) * (1.f / 1024.f) + EPS);
                    f32x4 hv[4];
#pragma unroll
                    for (int i = 0; i < 4; ++i) { hv[i] = (x[i] * rstd) * Ar[i] + Br[i];
                        if (P.H8) *(unsigned*)(P.H8 + row * 1024 + 256 * i + 4 * lane) = pk8x4(hv[i][0], hv[i][1], hv[i][2], hv[i][3]);
                        if (P.H) { u32x2 w; w.x = pk2(hv[i][0], hv[i][1]); w.y = pk2(hv[i][2], hv[i][3]); *(u32x2*)(P.H + row * 1024 + 256 * i + 4 * lane) = w; } }
                    if (P.route) {
                        float lg[8];
#pragma unroll
                        for (int e = 0; e < 8; ++e) lg[e] = 0.f;
#pragma unroll
                        for (int i = 0; i < 4; ++i)
#pragma unroll
                            for (int j = 0; j < 4; ++j) { const LAS f32x4* w = (const LAS f32x4*)(RW + (256 * i + 4 * lane + j) * 8); const f32x4 w0 = w[0], w1 = w[1]; const float hvv = hv[i][j];
                                lg[0] += hvv * w0[0]; lg[1] += hvv * w0[1]; lg[2] += hvv * w0[2]; lg[3] += hvv * w0[3]; lg[4] += hvv * w1[0]; lg[5] += hvv * w1[1]; lg[6] += hvv * w1[2]; lg[7] += hvv * w1[3]; }
#pragma unroll
                        for (int e = 0; e < 8; ++e) lg[e] = wave_sum(lg[e]);
                        if (lane == 0) {
                            int e1 = 0; float v1 = lg[0];
#pragma unroll
                            for (int e = 1; e < 8; ++e) if (lg[e] > v1) { v1 = lg[e]; e1 = e; }
                            int e2 = -1; float v2 = -3.0e38f;
#pragma unroll
                            for (int e = 0; e < 8; ++e) if (e != e1 && lg[e] > v2) { v2 = lg[e]; e2 = e; }
                            const float p2 = rcp(1.f + ex2(LOG2E * (v1 - v2))), p1 = 1.f - p2;
                            const int k1 = LC[wid * 8 + e1]; LC[wid * 8 + e1] = k1 + 1; const int k2 = LC[wid * 8 + e2]; LC[wid * 8 + e2] = k2 + 1;
                            LAS int* rc = REC + rl * 8; rc[0] = e1; rc[1] = k1; rc[2] = e2; rc[3] = k2; rc[4] = __builtin_bit_cast(int, p1); rc[5] = __builtin_bit_cast(int, p2);
                        }
                    }
                }
            }
        }
        if (P.route) {
            __syncthreads();
            if (tid < 64) { const int e = tid & 7, w = tid >> 3; int off = 0; for (int w2 = 0; w2 < w; ++w2) off += LC[w2 * 8 + e]; LC[64 + w * 8 + e] = off;
                if (w == 7) P.cnt[rb * 8 + e] = (unsigned)(off + LC[56 + e]); }
            __syncthreads();
            if (tid < 64) { const LAS int* rc = REC + tid * 8; const size_t row = (size_t)rb * 64 + tid; const int w = tid >> 3; const int e1 = rc[0], e2 = rc[2]; const int s1 = LC[64 + w * 8 + e1] + rc[1], s2 = LC[64 + w * 8 + e2] + rc[3];
                ((int*)(a->ws + WS_LIST))[(rb * 8 + e1) * 64 + s1] = (int)row; ((int*)(a->ws + WS_LIST))[(rb * 8 + e2) * 64 + s2] = (int)row;
                ((int*)(a->ws + WS_TOKE))[row] = e1 | (e2 << 8); ((int*)(a->ws + WS_TOKS))[row * 2] = s1; ((int*)(a->ws + WS_TOKS))[row * 2 + 1] = s2;
                ((int*)(a->ws + WS_TOKP))[row * 2] = rc[4]; ((int*)(a->ws + WS_TOKP))[row * 2 + 1] = rc[5]; }
        }
    }
    __syncthreads();
}

__device__ __forceinline__ void conv_unit(LAS unsigned char* lds, ArgsP a, int l, int u) {
    const int tid = ltid(), lane = tid & 63, wid = __builtin_amdgcn_readfirstlane(tid >> 6);
    const int b = u >> 7, t0 = (u & 127) * 32; const size_t rowb = (size_t)b * SEQ;
    const bf16_t* Z = (const bf16_t*)(a->ws + WS_R1);
    LAS bf16_t* IN = (LAS bf16_t*)lds;
    LAS float* RED = (LAS float*)lds;
    LAS float* FIN = (LAS float*)(lds + 4096);
    { u32x4 v[8];
#pragma unroll
      for (int x = 0; x < 8; ++x) { const int idx = tid + 512 * x, r = idx >> 6, ch = idx & 63; const int tok = t0 - 30 + r;
          v[x] = (u32x4){0u, 0u, 0u, 0u}; if (r < 62 && tok >= 0) v[x] = *(const u32x4*)(Z + (rowb + tok) * ZP + ZC_GLU + ch * 8); }
#pragma unroll
      for (int x = 0; x < 8; ++x) { const int idx = tid + 512 * x, r = idx >> 6, ch = idx & 63; if (r < 62) *(LAS u32x4*)(IN + r * 512 + ch * 8) = v[x]; } }
    const int c = tid; float w[31];
#pragma unroll
    for (int j = 0; j < 31; ++j) w[j] = a->in[I_CDW][(size_t)l * 31 * 512 + j * 512 + c];
    const float bias = a->in[I_CDWB][l * 512 + c];
    __syncthreads();
    float xr[62];
#pragma unroll
    for (int r = 0; r < 62; ++r) xr[r] = bf2f(IN[r * 512 + c]);
    f32x2 xe[31], xo[31];
#pragma unroll
    for (int k = 0; k < 31; ++k) { xe[k] = (f32x2){xr[2 * k], xr[2 * k + 1]}; xo[k] = (f32x2){xr[2 * k + 1], xr[(2 * k + 2) < 62 ? 2 * k + 2 : 61]}; }
    float acc[32];
#pragma unroll
    for (int u2 = 0; u2 < 16; ++u2) { f32x2 s2 = {bias, bias};
#pragma unroll
        for (int j = 0; j < 31; ++j) { const int r = 2 * u2 + j; s2 = s2 + ((r & 1) ? xo[r >> 1] : xe[r >> 1]) * w[j]; }
        acc[2 * u2] = s2.x; acc[2 * u2 + 1] = s2.y; }
    LAS float* ACC = (LAS float*)(lds + 63488);
#pragma unroll
    for (int t = 0; t < 32; ++t) ACC[t * 513 + c] = acc[t];
    __syncthreads();
    { const int t = tid & 31, sgm = tid >> 5; const LAS float* p = ACC + t * 513 + sgm * 32; float s1 = 0.f, s2 = 0.f;
#pragma unroll
      for (int k = 0; k < 32; ++k) { const float v = p[k]; s1 += v; s2 += v * v; }
      RED[(sgm * 32 + t) * 2] = s1; RED[(sgm * 32 + t) * 2 + 1] = s2; }
    __syncthreads();
    if (tid < 32) { float s1 = 0.f, s2 = 0.f;
#pragma unroll
        for (int wv = 0; wv < 16; ++wv) { s1 += RED[(wv * 32 + tid) * 2]; s2 += RED[(wv * 32 + tid) * 2 + 1]; }
        const float mu = s1 * (1.f / 512.f), var = fmaxf(s2 * (1.f / 512.f) - mu * mu, 0.f); FIN[tid * 2] = mu; FIN[tid * 2 + 1] = 1.0f / sqrtf(var + EPS); }
    __syncthreads();
    const float g = a->in[I_CLNG][l * 512 + c], be = a->in[I_CLNB][l * 512 + c];
    bf16_t* O = (bf16_t*)(a->ws + WS_RM);
#pragma unroll
    for (int t = 0; t < 32; ++t) { const float yv = (acc[t] - FIN[t * 2]) * FIN[t * 2 + 1] * g + be; O[(rowb + t0 + t) * ABCP + c] = (bf16_t)f2bf(silu(yv)); }
}

constexpr int SB_KP = 144;
__device__ __forceinline__ void sb_unit(LAS unsigned char* lds, ArgsP a, int bh, int qb) {
    const int tid = ltid(), lane = tid & 63, wid = __builtin_amdgcn_readfirstlane(tid >> 6), r32 = lane & 31, hi = lane >> 5;
    const int b = bh >> 3, h = bh & 7; const size_t rowb = (size_t)b * SEQ; const int q0 = qb * 256;
    const bf16_t* Z = (const bf16_t*)(a->ws + WS_R1);
    const bf16_t* Zq = Z + ZC_SQ + h * 64; const bf16_t* Zk = Z + ZC_SK + h * 64; const bf16_t* Zv = Z + ZC_SV + h * 64;
    bf16x8 qr[4];
    { const bf16_t* qp = Zq + (rowb + q0 + wid * 32 + r32) * ZP + hi * 8;
#pragma unroll
      for (int d0 = 0; d0 < 4; ++d0) qr[d0] = *(const bf16x8*)(qp + d0 * 16); }
    f32x16 o0, o1;
#pragma unroll
    for (int r = 0; r < 16; ++r) { o0[r] = 0.f; o1[r] = 0.f; }
    float carry = 1.f;
    const int NT = (q0 + 256) / 64;
    const int lrow = tid >> 3, lch = tid & 7;
    const bf16_t* kg = Zk + (rowb + lrow) * ZP + lch * 8; const bf16_t* vg = Zv + (rowb + lrow) * ZP + lch * 8;
    const int KOFF = 0, VOFF = 2 * 64 * SB_KP, BUFB = 64 * SB_KP;
    const int lst = lrow * SB_KP + lch * 16;
    u32x4 kreg = *(const u32x4*)(kg + (size_t)(NT - 1) * 64 * ZP), vreg = *(const u32x4*)(vg + (size_t)(NT - 1) * 64 * ZP);
    *(LAS u32x4*)(lds + KOFF + lst) = kreg; *(LAS u32x4*)(lds + VOFF + lst) = vreg;
    __syncthreads();
    const int qmin = q0 + wid * 32, qmax = qmin + 31, qme = qmin + r32;
    const int kvrow0 = 32 * ((r32 >> 2) & 1) + (r32 & 3) + 4 * (r32 >> 3);
    const int li = lane & 15, lblk = (lane >> 4) & 1;
    const int vtr0 = (32 * hi + (li >> 2)) * SB_KP + (16 * lblk + 4 * (li & 3)) * 2;
    LAS int* ALV = (LAS int*)(lds + 4 * 64 * SB_KP);
    bool dead = false;
    for (int kt = NT - 1; kt >= 0; --kt) {
        const int buf = (NT - 1 - kt) & 1;
        if (kt > 0) { kreg = *(const u32x4*)(kg + (size_t)(kt - 1) * 64 * ZP); vreg = *(const u32x4*)(vg + (size_t)(kt - 1) * 64 * ZP); }
        if (kt * 64 < qmax && !dead) {
            const LAS unsigned char* Kb = lds + KOFF + buf * BUFB; const LAS unsigned char* Vb = lds + VOFF + buf * BUFB;
            f32x16 p0, p1;
#pragma unroll
            for (int r = 0; r < 16; ++r) { p0[r] = 0.f; p1[r] = 0.f; }
#pragma unroll
            for (int d0 = 0; d0 < 4; ++d0) {
                const bf16x8 a0 = *(const LAS bf16x8*)(Kb + kvrow0 * SB_KP + (d0 * 16 + hi * 8) * 2);
                const bf16x8 a1 = *(const LAS bf16x8*)(Kb + (kvrow0 + 16) * SB_KP + (d0 * 16 + hi * 8) * 2);
                p0 = __builtin_amdgcn_mfma_f32_32x32x16_bf16(a0, qr[d0], p0, 0, 0, 0);
                p1 = __builtin_amdgcn_mfma_f32_32x32x16_bf16(a1, qr[d0], p1, 0, 0, 0);
            }
            const bool diag = (kt * 64 + 63 >= qmin);
            const int kv0 = kt * 64 + 32 * hi;
            f32x2 Ec1 = {1.f, 1.f}, Ec0 = {1.f, 1.f}, Pc1 = {1.f, 1.f}, Pc0 = {1.f, 1.f}, dd1[8], dd0[8];
#define SB_CL(x) __builtin_amdgcn_fmed3f((x), -15.f, 3.0e38f)
#define SB_CHAINS(MASKED) do { \
            _Pragma("unroll") for (int i = 7; i >= 0; --i) { \
                f32x2 e1 = {ex2(-SB_CL(p1[8 + i])), ex2(-SB_CL(p1[i]))}, e0 = {ex2(-SB_CL(p0[8 + i])), ex2(-SB_CL(p0[i]))}; \
                f32x2 d1 = e1 + 1.0f, d0 = e0 + 1.0f; \
                if (MASKED) { const bool mA = kv0 + 24 + i >= qme, mB = kv0 + 16 + i >= qme, mC = kv0 + 8 + i >= qme, mD = kv0 + i >= qme; \
                    e1.x = mA ? 1.f : e1.x; d1.x = mA ? 1.f : d1.x; e1.y = mB ? 1.f : e1.y; d1.y = mB ? 1.f : d1.y; e0.x = mC ? 1.f : e0.x; d0.x = mC ? 1.f : d0.x; e0.y = mD ? 1.f : e0.y; d0.y = mD ? 1.f : d0.y; } \
                dd1[i] = d1; dd0[i] = d0; \
                p1[8 + i] = Ec1.x; p1[i] = Ec1.y; p0[8 + i] = Ec0.x; p0[i] = Ec0.y; \
                Ec1 = Ec1 * e1; Ec0 = Ec0 * e0; } \
            _Pragma("unroll") for (int i = 0; i < 8; ++i) { \
                f32x2 w1 = (f32x2){p1[8 + i], p1[i]} * Pc1, w0 = (f32x2){p0[8 + i], p0[i]} * Pc0; \
                if (MASKED) { w1.x = (kv0 + 24 + i >= qme) ? 0.f : w1.x; w1.y = (kv0 + 16 + i >= qme) ? 0.f : w1.y; w0.x = (kv0 + 8 + i >= qme) ? 0.f : w0.x; w0.y = (kv0 + i >= qme) ? 0.f : w0.y; } \
                Pc1 = Pc1 * dd1[i]; Pc0 = Pc0 * dd0[i]; \
                p1[8 + i] = w1.x; p1[i] = w1.y; p0[8 + i] = w0.x; p0[i] = w0.y; } } while (0)
            if (diag) SB_CHAINS(true); else SB_CHAINS(false);
#undef SB_CHAINS
#undef SB_CL
            const float rA = rcp(Pc1.x), rB = rcp(Pc1.y), rC = rcp(Pc0.x), rD = rcp(Pc0.y);
            const float kA = Ec1.x * rA, kB = Ec1.y * rB, kC = Ec0.x * rC, kD = Ec0.y * rD;
            const float L = (kA * kB) * (kC * kD);
            const float Lo = __shfl_xor(L, 32);
            const float start = hi ? carry : carry * Lo;
            carry = carry * L * Lo;
            dead = !__any(carry >= 1.1754944e-38f);
            const float tA = start, tB = tA * kA, tC = tB * kB, tD = tC * kC;
            const float sA = tA * rA, sB = tB * rB, sC = tC * rC, sD = tD * rD;
            bf16x8 pf[4];
            { u32x4 w;
              w.x = pk2(p0[0] * sD, p0[1] * sD); w.y = pk2(p0[2] * sD, p0[3] * sD); w.z = pk2(p0[4] * sD, p0[5] * sD); w.w = pk2(p0[6] * sD, p0[7] * sD); pf[0] = __builtin_bit_cast(bf16x8, w);
              w.x = pk2(p0[8] * sC, p0[9] * sC); w.y = pk2(p0[10] * sC, p0[11] * sC); w.z = pk2(p0[12] * sC, p0[13] * sC); w.w = pk2(p0[14] * sC, p0[15] * sC); pf[1] = __builtin_bit_cast(bf16x8, w);
              w.x = pk2(p1[0] * sB, p1[1] * sB); w.y = pk2(p1[2] * sB, p1[3] * sB); w.z = pk2(p1[4] * sB, p1[5] * sB); w.w = pk2(p1[6] * sB, p1[7] * sB); pf[2] = __builtin_bit_cast(bf16x8, w);
              w.x = pk2(p1[8] * sA, p1[9] * sA); w.y = pk2(p1[10] * sA, p1[11] * sA); w.z = pk2(p1[12] * sA, p1[13] * sA); w.w = pk2(p1[14] * sA, p1[15] * sA); pf[3] = __builtin_bit_cast(bf16x8, w); }
#pragma unroll
            for (int ks = 0; ks < 4; ++ks) {
                const LAS unsigned char* vp = Vb + vtr0 + (8 * ks) * SB_KP;
                const bf16x8 v0 = cat8(trrd(vp), trrd(vp + 4 * SB_KP));
                const bf16x8 v1 = cat8(trrd(vp + 64), trrd(vp + 4 * SB_KP + 64));
                o0 = __builtin_amdgcn_mfma_f32_32x32x16_bf16(pf[ks], v0, o0, 0, 0, 0);
                o1 = __builtin_amdgcn_mfma_f32_32x32x16_bf16(pf[ks], v1, o1, 0, 0, 0);
            }
        }
        if (lane == 0) ALV[(kt & 1) * 8 + wid] = dead ? 0 : 1;
        if (kt > 0) { *(LAS u32x4*)(lds + KOFF + (buf ^ 1) * BUFB + lst) = kreg; *(LAS u32x4*)(lds + VOFF + (buf ^ 1) * BUFB + lst) = vreg; }
        __syncthreads();
        { const LAS int* av = ALV + (kt & 1) * 8; if (((av[0] | av[1]) | (av[2] | av[3])) == 0 && ((av[4] | av[5]) | (av[6] | av[7])) == 0) break; }
    }
    bf16_t* O = (bf16_t*)(a->ws + WS_RM) + 512 + h * 64;
#pragma unroll
    for (int r = 0; r < 16; ++r) { const size_t row = rowb + q0 + wid * 32 + crow(r, hi); O[row * ABCP + r32] = (bf16_t)f2bf(o0[r]); O[row * ABCP + 32 + r32] = (bf16_t)f2bf(o1[r]); }
}

constexpr int GP = 272;
constexpr int G_GL = 0, G_TOT = 4096, G_T0 = 8192, G_T1 = G_T0 + 64 * GP, G_T2 = G_T1 + 64 * GP;
constexpr size_t GS_QD = 0, GS_OI = (size_t)1024 * 64 * 128 * 2, GS_DS = 2 * GS_OI;
__device__ __forceinline__ unsigned fbits(float x) { return __builtin_bit_cast(unsigned, x); }
__device__ __forceinline__ void lds_barrier() { asm volatile("s_waitcnt lgkmcnt(0)" ::: "memory"); __builtin_amdgcn_s_barrier(); asm volatile("" ::: "memory"); }
__device__ __forceinline__ void st_wt16(void* p, u32x4 v) { asm volatile("global_store_dwordx4 %0, %1, off sc1\n\ts_nop 1" :: "v"(p), "v"(v) : "memory"); }
__device__ __forceinline__ void gla_chunk_unit(LAS unsigned char* lds, ArgsP a, int l, int cu, unsigned* gcnt, int pend) {
    const int tid = ltid(), lane = tid & 63, wid = __builtin_amdgcn_readfirstlane(tid >> 6), r32 = lane & 31, hi = lane >> 5;
    const int bh = cu >> 6, n = cu & 63, b = bh >> 2, h = bh & 3; const size_t row0 = (size_t)b * SEQ + n * 64;
    const bf16_t* Z = (const bf16_t*)(a->ws + WS_R1);
    const int jb = wid & 3, tbp = wid >> 2;
    const int j = 32 * jb + r32, g = 2 * tbp + hi;
    LAS unsigned char* QD = lds + G_T0; LAS unsigned char* KI = lds + G_T1; LAS unsigned char* VT = lds + G_T2; LAS unsigned char* KE = lds + G_T2 + 64 * GP;
    LAS float* TOT = (LAS float*)(lds + G_TOT);
    const int pir = 16 * ((r32 >> 2) & 1) + (r32 & 3) + 4 * (r32 >> 3);
    const bf16x8 glf = *(const bf16x8*)(Z + (row0 + 32 * tbp + pir) * ZP + ZC_GLR + 8 * hi);
    float a2v[8];
#pragma unroll
    for (int e = 0; e < 8; ++e) a2v[e] = a->in[I_GA2][(size_t)l * 16 * 512 + (8 * hi + e) * 512 + h * 128 + j];
    const float abj = a->in[I_GAB][l * 512 + h * 128 + j];
    unsigned short qraw[16], kraw[16];
#pragma unroll
    for (int i = 0; i < 16; ++i) { const size_t rr = (row0 + 16 * g + i) * ZP + h * 128 + j; qraw[i] = Z[rr + ZC_GQ]; kraw[i] = Z[rr + ZC_GK]; }
    u32x4 vraw[2];
#pragma unroll
    for (int x = 0; x < 2; ++x) { const int idx = tid + 512 * x, t = idx >> 4, ch = idx & 15; vraw[x] = *(const u32x4*)(Z + (row0 + t) * ZP + ZC_GV + h * 128 + ch * 8); }
#pragma unroll
    for (int x = 0; x < 2; ++x) { const int idx = tid + 512 * x, t = idx >> 4, ch = idx & 15; *(LAS u32x4*)(VT + t * GP + ch * 16) = vraw[x]; }
    f32x16 uu;
    { u32x4 wh, wl; float lo[8];
#pragma unroll
      for (int e = 0; e < 8; ++e) lo[e] = a2v[e] - bf2f(f2bf(a2v[e]));
      wh.x = pk2(a2v[0], a2v[1]); wh.y = pk2(a2v[2], a2v[3]); wh.z = pk2(a2v[4], a2v[5]); wh.w = pk2(a2v[6], a2v[7]);
      wl.x = pk2(lo[0], lo[1]); wl.y = pk2(lo[2], lo[3]); wl.z = pk2(lo[4], lo[5]); wl.w = pk2(lo[6], lo[7]);
#pragma unroll
      for (int r = 0; r < 16; ++r) uu[r] = abj;
      uu = __builtin_amdgcn_mfma_f32_32x32x16_bf16(glf, __builtin_bit_cast(bf16x8, wh), uu, 0, 0, 0);
      uu = __builtin_amdgcn_mfma_f32_32x32x16_bf16(glf, __builtin_bit_cast(bf16x8, wl), uu, 0, 0, 0); }
    float bc[16]; float run = 0.f;
#pragma unroll
    for (int i = 0; i < 16; ++i) { run += logsig(uu[i]) * 0.0625f; bc[i] = run; }
    TOT[g * 128 + j] = run;
    asm volatile("s_waitcnt vmcnt(0)" ::: "memory");
    __syncthreads();
    if (pend >= 0 && tid == 0) __hip_atomic_fetch_add(gcnt + pend * 64, 1u, __ATOMIC_RELAXED, __HIP_MEMORY_SCOPE_AGENT);
    float off = 0.f, blast = 0.f;
#pragma unroll
    for (int g2 = 0; g2 < 4; ++g2) { const float v = TOT[g2 * 128 + j]; blast += v; if (g2 < g) off += v; }
    const float dec = ex2(LOG2E * blast);
#pragma unroll
    for (int i = 0; i < 16; i += 2) { const int t = 16 * g + i;
        const float e0 = ex2(LOG2E * (bc[i] + off)), e1 = ex2(LOG2E * (bc[i + 1] + off)), k0 = bf2f(kraw[i]) * rcp(e0), k1 = bf2f(kraw[i + 1]) * rcp(e1);
        const unsigned wq = pk2(bf2f(qraw[i]) * e0, bf2f(qraw[i + 1]) * e1), wk = pk2(k0, k1), we = pk2(k0 * dec, k1 * dec);
        *(LAS bf16_t*)(QD + t * GP + j * 2) = (bf16_t)wq; *(LAS bf16_t*)(QD + (t + 1) * GP + j * 2) = (bf16_t)(wq >> 16);
        *(LAS bf16_t*)(KI + t * GP + j * 2) = (bf16_t)wk; *(LAS bf16_t*)(KI + (t + 1) * GP + j * 2) = (bf16_t)(wk >> 16);
        *(LAS bf16_t*)(KE + t * GP + j * 2) = (bf16_t)we; *(LAS bf16_t*)(KE + (t + 1) * GP + j * 2) = (bf16_t)(we >> 16); }
    if (g == 0) __hip_atomic_store((float*)(a->ws + WS_DECAY) + (size_t)cu * 128 + j, dec, __ATOMIC_RELAXED, __HIP_MEMORY_SCOPE_AGENT);
    lds_barrier();
    { bf16_t* QDg = (bf16_t*)(a->ws + WS_RY + GS_QD) + (size_t)cu * 8192;
#pragma unroll
      for (int x = 0; x < 2; ++x) { const int idx = tid + 512 * x, t = idx >> 4, ch = idx & 15; st_wt16(QDg + t * 128 + ch * 8, *(const LAS u32x4*)(QD + t * GP + ch * 16)); } }
    { const int jvb = wid >> 1, jkb0 = 2 * (wid & 1); const int li2 = lane & 15, lblk2 = (lane >> 4) & 1;
      const int trb = (8 * hi + (li2 >> 2)) * GP + (16 * lblk2 + 4 * (li2 & 3)) * 2;
      f32x16 c0, c1;
#pragma unroll
      for (int r = 0; r < 16; ++r) { c0[r] = 0.f; c1[r] = 0.f; }
#pragma unroll
      for (int kt = 0; kt < 4; ++kt) {
          const LAS unsigned char* vp = VT + trb + (16 * kt) * GP + (32 * jvb) * 2; const LAS unsigned char* kp = KE + trb + (16 * kt) * GP + (32 * jkb0) * 2;
          const bf16x8 af = cat8(trrd(vp), trrd(vp + 4 * GP));
          const bf16x8 b0 = cat8(trrd(kp), trrd(kp + 4 * GP)), b1 = cat8(trrd(kp + 64), trrd(kp + 4 * GP + 64));
          c0 = __builtin_amdgcn_mfma_f32_32x32x16_bf16(af, b0, c0, 0, 0, 0); c1 = __builtin_amdgcn_mfma_f32_32x32x16_bf16(af, b1, c1, 0, 0, 0);
      }
      bf16_t* DS = (bf16_t*)(a->ws + WS_RY + GS_DS) + (size_t)cu * 16384 + tid * 8;
#pragma unroll
      for (int q4 = 0; q4 < 2; ++q4) { st_wt16(DS + 4096 * q4, (u32x4){pk2(c0[8 * q4], c0[8 * q4 + 1]), pk2(c0[8 * q4 + 2], c0[8 * q4 + 3]), pk2(c0[8 * q4 + 4], c0[8 * q4 + 5]), pk2(c0[8 * q4 + 6], c0[8 * q4 + 7])});
          st_wt16(DS + 8192 + 4096 * q4, (u32x4){pk2(c1[8 * q4], c1[8 * q4 + 1]), pk2(c1[8 * q4 + 2], c1[8 * q4 + 3]), pk2(c1[8 * q4 + 4], c1[8 * q4 + 5]), pk2(c1[8 * q4 + 6], c1[8 * q4 + 7])}); } }
    const int tb = wid & 1, jq = wid >> 1; const int li = lane & 15, lblk = (lane >> 4) & 1;
    bf16x8 pf[2][2];
#pragma unroll
    for (int sb = 0; sb < 2; ++sb) {
        if (sb <= tb) {
            f32x16 d;
#pragma unroll
            for (int r = 0; r < 16; ++r) d[r] = 0.f;
#pragma unroll
            for (int kk = 0; kk < 8; ++kk) { const bf16x8 af = *(const LAS bf16x8*)(KI + (32 * sb + r32) * GP + (16 * kk + 8 * hi) * 2), bf = *(const LAS bf16x8*)(QD + (32 * tb + r32) * GP + (16 * kk + 8 * hi) * 2);
                d = __builtin_amdgcn_mfma_f32_32x32x16_bf16(af, bf, d, 0, 0, 0); }
            if (sb == tb) {
#pragma unroll
                for (int r = 0; r < 16; ++r) if (crow(r, hi) > r32) d[r] = 0.f;
            }
#pragma unroll
            for (int st = 0; st < 2; ++st) { u32x4 w; w.x = pk2(d[8 * st + 0], d[8 * st + 1]); w.y = pk2(d[8 * st + 2], d[8 * st + 3]); w.z = pk2(d[8 * st + 4], d[8 * st + 5]); w.w = pk2(d[8 * st + 6], d[8 * st + 7]); pf[sb][st] = __builtin_bit_cast(bf16x8, w); }
        } else { pf[sb][0] = (bf16x8){0, 0, 0, 0, 0, 0, 0, 0}; pf[sb][1] = (bf16x8){0, 0, 0, 0, 0, 0, 0, 0}; }
    }
    f32x16 o;
#pragma unroll
    for (int r = 0; r < 16; ++r) o[r] = 0.f;
#pragma unroll
    for (int sb = 0; sb < 2; ++sb)
#pragma unroll
        for (int st = 0; st < 2; ++st) {
            const LAS unsigned char* vp = VT + (32 * sb + 16 * st + 4 * hi + (li >> 2)) * GP + (32 * jq + 16 * lblk + 4 * (li & 3)) * 2;
            const bf16x8 af = cat8(trrd(vp), trrd(vp + 8 * GP));
            o = __builtin_amdgcn_mfma_f32_32x32x16_bf16(af, pf[sb][st], o, 0, 0, 0);
        }
    { bf16_t* OI = (bf16_t*)(a->ws + WS_RY + GS_OI) + (size_t)cu * 8192 + tid * 8;
#pragma unroll
      for (int q4 = 0; q4 < 2; ++q4) st_wt16(OI + 4096 * q4, (u32x4){pk2(o[8 * q4], o[8 * q4 + 1]), pk2(o[8 * q4 + 2], o[8 * q4 + 3]), pk2(o[8 * q4 + 4], o[8 * q4 + 5]), pk2(o[8 * q4 + 6], o[8 * q4 + 7])}); }
}
constexpr size_t GS_SN = 0;
__device__ __forceinline__ void gla_scan_unit(ArgsP a, int bh, int q, unsigned* sdone) {
    const int tid = ltid(), lane = tid & 63, wid = __builtin_amdgcn_readfirstlane(tid >> 6), r32 = lane & 31;
    const int jkb = 2 * (wid & 1) + (q >> 1);
    const bf16_t* DSg = (const bf16_t*)(a->ws + WS_RY + GS_DS) + (size_t)bh * 64 * 16384 + 4096 * q + tid * 8;
    bf16_t* SNg = (bf16_t*)(a->ws + WS_MRG + GS_SN) + (size_t)bh * 64 * 16384 + 4096 * q + tid * 8;
    const float* DECg = (const float*)(a->ws + WS_DECAY) + (size_t)bh * 64 * 128 + 32 * jkb + r32;
    float st[8];
#pragma unroll
    for (int i = 0; i < 8; ++i) st[i] = 0.f;
    u32x4 dv[16]; float dc[16];
#pragma unroll
    for (int k = 0; k < 16; ++k) { dv[k] = *(const u32x4*)(DSg + (size_t)k * 16384); dc[k] = DECg[k * 128]; }
#pragma unroll 1
    for (int nb = 0; nb < 64; nb += 16) {
        u32x4 dn[16]; float cn[16];
        const int nn = nb + 16 < 64 ? nb + 16 : nb;
#pragma unroll
        for (int k = 0; k < 16; ++k) { dn[k] = *(const u32x4*)(DSg + (size_t)(nn + k) * 16384); cn[k] = DECg[(nn + k) * 128]; }
#pragma unroll
        for (int k = 0; k < 16; ++k) {
            st_wt16(SNg + (size_t)(nb + k) * 16384, (u32x4){pk2(st[0], st[1]), pk2(st[2], st[3]), pk2(st[4], st[5]), pk2(st[6], st[7])});
            st[0] = st[0] * dc[k] + bflo(dv[k].x); st[1] = st[1] * dc[k] + bfhi(dv[k].x); st[2] = st[2] * dc[k] + bflo(dv[k].y); st[3] = st[3] * dc[k] + bfhi(dv[k].y);
            st[4] = st[4] * dc[k] + bflo(dv[k].z); st[5] = st[5] * dc[k] + bfhi(dv[k].z); st[6] = st[6] * dc[k] + bflo(dv[k].w); st[7] = st[7] * dc[k] + bfhi(dv[k].w); }
#pragma unroll
        for (int k = 0; k < 16; ++k) { dv[k] = dn[k]; dc[k] = cn[k]; }
    }
    asm volatile("s_waitcnt vmcnt(0)" ::: "memory");
    __syncthreads();
    if (tid == 0) __hip_atomic_fetch_add(sdone + bh * 64, 1u, __ATOMIC_RELAXED, __HIP_MEMORY_SCOPE_AGENT);
}
constexpr int R_SS = 0, R_QD = 1024, R_SL = R_QD + 64 * GP, R_SG = R_SL + 128 * GP, R_END = R_SG + 64 * GP;
static_assert(R_END <= RING_BYTES, "GLA LDS map");
__device__ __forceinline__ void gla_out_unit(LAS unsigned char* lds, ArgsP a, int l, int cu) {
    const int tid = ltid(), lane = tid & 63, wid = __builtin_amdgcn_readfirstlane(tid >> 6), r32 = lane & 31, hi = lane >> 5;
    const int bh = cu >> 6, n = cu & 63, b = bh >> 2, h = bh & 3; const size_t row0 = (size_t)b * SEQ + n * 64;
    const bf16_t* Z = (const bf16_t*)(a->ws + WS_R1);
    LAS float* SS = (LAS float*)(lds + R_SS);
    LAS unsigned char* QD = lds + R_QD; LAS unsigned char* SL = lds + R_SL;
    const int tb = wid & 1, jq = wid >> 1, jvb = wid >> 1, jkb0 = 2 * (wid & 1);
    const int sl_li = lane & 15, sl_tr = (8 * hi + (sl_li >> 2)) * GP + (32 * jq + 16 * ((lane >> 4) & 1) + 4 * (sl_li & 3)) * 2;
    const int t0 = tid >> 4, ch0 = tid & 15;
    const bf16_t* QDg = (const bf16_t*)(a->ws + WS_RY + GS_QD) + (size_t)cu * 8192;
    u32x4 qv[2], sn[4], oi[2], sgv[2]; u32x2 sg[4]; f32x4 gn[4];
#pragma unroll
    for (int x = 0; x < 2; ++x) qv[x] = *(const u32x4*)(QDg + (t0 + 32 * x) * 128 + ch0 * 8);
#pragma unroll
    for (int x = 0; x < 4; ++x) sn[x] = *(const u32x4*)((const bf16_t*)(a->ws + WS_MRG + GS_SN) + (size_t)cu * 16384 + 4096 * x + tid * 8);
#pragma unroll
    for (int x = 0; x < 2; ++x) oi[x] = *(const u32x4*)((const bf16_t*)(a->ws + WS_RY + GS_OI) + (size_t)cu * 8192 + 4096 * x + tid * 8);
    const size_t tok = row0 + 32 * tb + r32;
#pragma unroll
    for (int rg = 0; rg < 4; ++rg) gn[rg] = *(const f32x4*)(a->in[I_GNG] + l * 512 + h * 128 + 32 * jq + 8 * rg + 4 * hi);
#pragma unroll
    for (int x = 0; x < 2; ++x) sgv[x] = *(const u32x4*)(Z + (row0 + t0 + 32 * x) * ZP + ZC_GG + h * 128 + ch0 * 8);
#pragma unroll
    for (int x = 0; x < 2; ++x) { *(LAS u32x4*)(QD + (t0 + 32 * x) * GP + ch0 * 16) = qv[x]; *(LAS u32x4*)(lds + R_SG + (t0 + 32 * x) * GP + ch0 * 16) = sgv[x]; }
#pragma unroll
    for (int g4 = 0; g4 < 4; ++g4) { const u32x4 v0 = sn[g4 >> 1], v1 = sn[2 + (g4 >> 1)];
        *(LAS u32x2*)(SL + (32 * jkb0 + r32) * GP + (32 * jvb + 8 * g4 + 4 * hi) * 2) = (g4 & 1) ? (u32x2){v0.z, v0.w} : (u32x2){v0.x, v0.y};
        *(LAS u32x2*)(SL + (32 * jkb0 + 32 + r32) * GP + (32 * jvb + 8 * g4 + 4 * hi) * 2) = (g4 & 1) ? (u32x2){v1.z, v1.w} : (u32x2){v1.x, v1.y}; }
    f32x16 o;
#pragma unroll
    for (int x = 0; x < 2; ++x) { o[8 * x] = bflo(oi[x].x); o[8 * x + 1] = bfhi(oi[x].x); o[8 * x + 2] = bflo(oi[x].y); o[8 * x + 3] = bfhi(oi[x].y);
        o[8 * x + 4] = bflo(oi[x].z); o[8 * x + 5] = bfhi(oi[x].z); o[8 * x + 6] = bflo(oi[x].w); o[8 * x + 7] = bfhi(oi[x].w); }
    __syncthreads();
#pragma unroll
    for (int rg = 0; rg < 4; ++rg) sg[rg] = *(const LAS u32x2*)(lds + R_SG + (32 * tb + r32) * GP + (32 * jq + 8 * rg + 4 * hi) * 2);
#pragma unroll
    for (int kk = 0; kk < 8; ++kk) { const LAS unsigned char* sp = SL + sl_tr + (16 * kk) * GP;
        const bf16x8 af = cat8(trrd(sp), trrd(sp + 4 * GP)), bf = *(const LAS bf16x8*)(QD + (32 * tb + r32) * GP + (16 * kk + 8 * hi) * 2);
        o = __builtin_amdgcn_mfma_f32_32x32x16_bf16(af, bf, o, 0, 0, 0); }
    float ss = 0.f;
#pragma unroll
    for (int r = 0; r < 16; ++r) ss += o[r] * o[r];
    ss += __shfl_xor(ss, 32);
    if (hi == 0) SS[jq * 64 + 32 * tb + r32] = ss;
    __syncthreads();
    { const float tot = (SS[32 * tb + r32] + SS[64 + 32 * tb + r32]) + (SS[128 + 32 * tb + r32] + SS[192 + 32 * tb + r32]);
      const float rstd = 1.0f / sqrtf(tot * (1.f / 128.f) + EPS);
#pragma unroll
      for (int rg = 0; rg < 4; ++rg) { const int col = 32 * jq + 8 * rg + 4 * hi;
          u32x2 w; w.x = pk2(o[4 * rg] * rstd * gn[rg][0] * bflo(sg[rg].x), o[4 * rg + 1] * rstd * gn[rg][1] * bfhi(sg[rg].x)); w.y = pk2(o[4 * rg + 2] * rstd * gn[rg][2] * bflo(sg[rg].y), o[4 * rg + 3] * rstd * gn[rg][3] * bfhi(sg[rg].y));
          *(LAS u32x2*)(QD + (32 * tb + r32) * GP + col * 2) = w; } }
    __syncthreads();
    { bf16_t* O = (bf16_t*)(a->ws + WS_RM) + row0 * ABCP + 1024 + h * 128;
#pragma unroll
      for (int x = 0; x < 2; ++x) *(u32x4*)(O + (size_t)(t0 + 32 * x) * ABCP + ch0 * 8) = *(const LAS u32x4*)(QD + (t0 + 32 * x) * GP + ch0 * 16); }
}
constexpr int NPHASE = 2 + 8 * NLAYER;
constexpr int CW_FLAG = 16384;
constexpr int CW_GCNT = 24576;
constexpr int CW_Q = 12288;
__device__ __forceinline__ ArgsP fresh_args() { const CAS void* p = (const CAS void*)__builtin_amdgcn_kernarg_segment_ptr(); asm volatile("" : "+s"(p)); return (ArgsP)p; }
#define PHASE_ENV ArgsP a = fresh_args(); const int G = lgrid(), c = lbid(); (void)G; (void)c; unsigned char* ws = a->ws; unsigned* ctl = (unsigned*)(ws + WS_CTL); (void)ctl; \
    bf16_t* Z = (bf16_t*)(ws + WS_R1); bf16_t* ACT = (bf16_t*)(ws + WS_R1); bf16_t* H = (bf16_t*)(ws + WS_H); bf16_t* Y = (bf16_t*)(ws + WS_RY); bf16_t* OE = (bf16_t*)(ws + WS_RY); \
    bf16_t* ABC = (bf16_t*)(ws + WS_RM); bf16_t* MRG = (bf16_t*)(ws + WS_MRG); float* XA = (float*)(ws + WS_RM); (void)Z; (void)ACT; (void)H; (void)Y; (void)OE; (void)ABC; (void)MRG; (void)XA;
__global__ void __launch_bounds__(512, 2) fwd_kernel(Args a_in) {
    extern __shared__ __attribute__((aligned(16))) unsigned char shm[];
    LAS unsigned char* lds = (LAS unsigned char*)shm;
    const int tid = threadIdx.x;
    unsigned* ctl0 = (unsigned*)(a_in.ws + WS_CTL);
    if (tid < 4) ((LAS unsigned*)(lds + MISC_OFF))[tid] = 0u;
    __syncthreads();
    XcdBarrier bar; bar.bar = ctl0 + CW_BAR; bar.x = 0; bar.st = nullptr;
    const int lo = a_in.ph_lo, hi = a_in.ph_hi;
    if (hi - lo > 1) bar = xcd_barrier_post(ctl0 + CW_BAR, (volatile LAS unsigned*)(lds + MISC_OFF));
#define IN(k) (lo <= (k) && (k) < hi)
#define SEAM(k) do { if (IN(k) && IN((k) + 1)) { XcdBarrier _b = bar; asm volatile("" : "+s"(_b.bar)); xcd_barrier(_b); } } while (0)
        LAS int* tab = (LAS int*)(lds + TAB_OFF);

    if (IN(0)) { PHASE_ENV p0_prologue(lds, a); }
    SEAM(0);
    if (IN(1)) { PHASE_ENV ThinP P{}; P.xsrc = a->in[I_X]; P.xsrcb = nullptr; P.xdst = nullptr; P.xdstb = (bf16_t*)a->out; P.post = 0; P.pre = 1; P.gpre = a->in[I_MPREG]; P.lpre = 0; P.sh_off = 0; P.sc_off = 1024; P.H = H; P.H8 = (unsigned char*)(a->ws + WS_HG8); P.route = 0; P.from_partials = 1; thin_phase<false>(lds, a, P); }
    SEAM(1);
    for (int l = 0; l < NLAYER; ++l) {
        const int pb = 2 + 8 * l, j = l >> 1;
        if (IN(pb + 0)) { PHASE_ENV
            if (l >= 2) { pg8::InSched S{G, c, (const char*)H, (const char*)(ws + WS_WIN) + (size_t)l * NIN * 1024 * 2, (size_t)256 * 1024, (size_t)256 * 1024, 0, 31 * 64};
                pg8::EpiInF8 E{Z}; pg8::gemm_phase<pg8::EpiInF8, pg8::InSched>(lds, 1024, 1024, 1024, S, E); }
            else {
                { pg8::InSched S{G, c, (const char*)(ws + WS_HG8), (const char*)(ws + WS_WIN) + (size_t)l * NIN * 1024 * 2 + (size_t)4608 * 2048 - (size_t)18 * 256 * 1024, (size_t)256 * 1024, (size_t)256 * 1024, 0, 768};
                  pg8::EpiInF8 E{Z}; pg8::gemm_phase<pg8::EpiInF8, pg8::InSched>(lds, 1024, 1024, 1024, S, E); }
                { pg8::InSched S{G, c, (const char*)H, (const char*)(ws + WS_WIN) + (size_t)l * NIN * 1024 * 2, (size_t)256 * 1024 * 2, (size_t)256 * 1024 * 2, 768, 31 * 64};
                  pg8::EpiIn E{Z}; pg8::gemm_phase<pg8::EpiIn, pg8::InSched>(lds, 1024, 1024, 1024, S, E); } }
        }
        SEAM(pb + 0);
        if (IN(pb + 1)) { PHASE_ENV
            unsigned* gcnt = ctl + CW_GCNT + 1024 * l; unsigned* sdone = ctl + CW_FLAG + 1024 * l; unsigned* tmo = ctl + CW_BAR + XB_TMO;
            unsigned* q0 = ctl + CW_Q + 64 * l; unsigned* q1 = q0 + 32;
            LAS int* slot = (LAS int*)(lds + TAB_OFF + 128);
            int nxt = 0; bool t0q0 = true; int pend = -1;
            int zv = 0; asm volatile("" : "+v"(zv));
            if (ltid() == 0) nxt = (int)__hip_atomic_fetch_add(q0 + zv, 1u, __ATOMIC_RELAXED, __HIP_MEMORY_SCOPE_AGENT);
            for (;;) {
                lds_barrier();
                if (ltid() == 0) { int v = nxt + (t0q0 ? 0 : 2048);
                    if (t0q0 && v >= 1088) { t0q0 = false; v = 2048 + (int)__hip_atomic_fetch_add(q1 + zv, 1u, __ATOMIC_RELAXED, __HIP_MEMORY_SCOPE_AGENT); }
                    *slot = v;
                    nxt = (int)__hip_atomic_fetch_add((t0q0 ? q0 : q1) + zv, 1u, __ATOMIC_RELAXED, __HIP_MEMORY_SCOPE_AGENT); }
                lds_barrier();
                const int u = *slot;
                if (u < 1024) { gla_chunk_unit(lds, a, l, u, gcnt, pend); pend = u >> 6; continue; }
                if (pend >= 0) { asm volatile("s_waitcnt vmcnt(0)" ::: "memory"); lds_barrier(); if (ltid() == 0) __hip_atomic_fetch_add(gcnt + pend * 64, 1u, __ATOMIC_RELAXED, __HIP_MEMORY_SCOPE_AGENT); pend = -1; }
                if (u >= 2048 + 2048) break;
                if (u < 1088 || u >= 2048 + 1024) {
                    if (ltid() == 0) { unsigned* w; unsigned need;
                        if (u < 1088) { w = gcnt + ((u - 1024) >> 2) * 64; need = 64u; } else { w = sdone + ((u - 2048 - 1024) >> 6) * 64; need = 4u; }
                        unsigned sp = 0;
                        while (__hip_atomic_load(w, __ATOMIC_RELAXED, __HIP_MEMORY_SCOPE_AGENT) < need) { __builtin_amdgcn_s_sleep(4);
                            if ((++sp & 255u) == 0u) { if (__hip_atomic_load(tmo, __ATOMIC_RELAXED, __HIP_MEMORY_SCOPE_AGENT) != 0u) break; if (sp > (1u << 22)) { __hip_atomic_store(tmo, 1u, __ATOMIC_RELAXED, __HIP_MEMORY_SCOPE_AGENT); break; } } }
                        __builtin_amdgcn_fence(__ATOMIC_ACQUIRE, "agent"); asm volatile("s_waitcnt vmcnt(0)" ::: "memory"); }
                    lds_barrier(); }
                if (u < 1088) gla_scan_unit(a, (u - 1024) >> 2, (u - 1024) & 3, sdone);
                else if (u < 2048 + 512) sb_unit(lds, a, (u - 2048) & 31, 15 - ((u - 2048) >> 5));
                else if (u < 2048 + 1024) conv_unit(lds, a, l, u - 2048 - 512);
                else gla_out_unit(lds, a, l, u - 2048 - 1024); }
        }
        SEAM(pb + 1);
        if (IN(pb + 2)) { PHASE_ENV
            pg8::CatSched S{G, c, (const char*)ABC, (const char*)(ws + WS_WCAT) + (size_t)l * 1024 * 1536 * 2, (size_t)256 * 1536 * 2, (size_t)256 * 1536 * 2};
            pg8::EpiMerge E{Z + ZC_GATE, MRG}; pg8::gemm_phase<pg8::EpiMerge, pg8::CatSched>(lds, 512, 1536, 1536, S, E);
        }
        SEAM(pb + 2);
        if (IN(pb + 3)) { PHASE_ENV
            pg8::DenseSched S{64, 4, G, c, (const char*)MRG, (const char*)(ws + WS_WO) + (size_t)l * 1024 * 1024 * 2, (size_t)256 * 1024 * 2, (size_t)256 * 1024 * 2};
            if (l & 1) { pg8::EpiBf16 E{Y, 1024}; pg8::gemm_phase<pg8::EpiBf16, pg8::DenseSched>(lds, 1024, 1024, 1024, S, E); }
            else {
                pg8::EpiFuse E{(const bf16_t*)a->out, (bf16_t*)XA, H, (const float*)(ws + WS_MODF), a->in[I_MPOSTG] + l * 1024, a->in[I_FPREG] + l * 1024, l, l, 2048, 4096, 3072,
                               (f32x4*)(ws + WS_OEX) + (size_t)(l >> 1) * 65536, ctl + CW_CNT + (l >> 1) * 64, ctl + CW_BAR + XB_TMO, l == 2 ? 1 : 0, nullptr};
                pg8::gemm_phase<pg8::EpiFuse, pg8::DenseSched>(lds, 1024, 1024, 1024, S, E); }
        }
        if (l & 1) SEAM(pb + 3);
        if ((l & 1) && IN(pb + 4)) { PHASE_ENV ThinP P{}; P.xsrc = nullptr; P.xsrcb = (const bf16_t*)a->out; P.xdst = nullptr; P.xdstb = (bf16_t*)XA; P.post = 1; P.y = Y; P.gpost = a->in[I_MPOSTG] + l * 1024; P.lpost = l; P.gate_off = 2048;
            P.pre = 1; P.gpre = a->in[I_FPREG] + l * 1024; P.lpre = l; P.sh_off = 3072; P.sc_off = 4096; P.H = nullptr; P.H8 = (unsigned char*)H; P.route = l & 1; P.rw = a->in[I_RW] + (size_t)j * 8192; P.cnt = ctl + CW_WCNT + j * 2048; P.from_partials = 0;
            thin_phase<true>(lds, a, P); }
        SEAM(pb + 4);
        if (l & 1) {
            if (IN(pb + 5)) { PHASE_ENV moe_table(tab, ctl + CW_WCNT + j * 2048);
                pg8::MoeSched<true> S{28, G, c, tab, (const char*)H, (const char*)(ws + WS_WMGU) + (size_t)j * 8 * 7168 * 1024, 0, (size_t)256 * 1024, (size_t)7168 * 1024, (const int*)(ws + WS_LIST), 1024u, 1 << 20};
                pg8::EpiSwigluF8 E{ACT, DFFE}; pg8::gemm_phase<pg8::EpiSwigluF8, pg8::MoeSched<true>>(lds, 1024, 1024, 1024, S, E); }
            SEAM(pb + 5);
            if (IN(pb + 6)) { PHASE_ENV moe_table(tab, ctl + CW_WCNT + j * 2048);
                pg8::MoeSched<false> S{4, G, c, tab, (const char*)ACT, (const char*)(ws + WS_WMDN) + (size_t)j * 8 * 1024 * DFFE, (size_t)256 * DFFE, (size_t)256 * DFFE, (size_t)1024 * DFFE, nullptr, 0u, 128};
                pg8::EpiBf16F8 E{OE, 1024}; pg8::gemm_phase<pg8::EpiBf16F8, pg8::MoeSched<false>>(lds, DFFE, DFFE, DFFE, S, E);
                pg8::MoeTailSched S2{G, c, tab, (const char*)ACT, (const char*)(ws + WS_WMDN) + (size_t)j * 8 * 1024 * DFFE, (size_t)256 * DFFE, (size_t)256 * DFFE, (size_t)1024 * DFFE};
                pg8::EpiF32F8 E2{(float*)(ws + WS_OEX), 1024}; pg8::gemm_phase<pg8::EpiF32F8, pg8::MoeTailSched>(lds, pg8::MoeTailSched::KS, DFFE, DFFE, S2, E2); }
        } else {
            if (IN(pb + 5)) { PHASE_ENV
                if (l == 2) { pg8::DenseSched S{64, 22, G, c, (const char*)H, (const char*)(ws + WS_WGU) + (size_t)5632 * 1024 * 2, (size_t)256 * 1024, (size_t)256 * 1024};
                    pg8::EpiSwigluF8 E{ACT, DFF}; pg8::gemm_phase<pg8::EpiSwigluF8, pg8::DenseSched>(lds, 1024, 1024, 1024, S, E); }
                else { pg8::DenseSched S{64, 22, G, c, (const char*)H, (const char*)(ws + WS_WGU) + (size_t)j * 5632 * 1024 * 2, (size_t)256 * 1024 * 2, (size_t)256 * 1024 * 2};
                    pg8::EpiSwiglu E{ACT, DFF}; pg8::gemm_phase<pg8::EpiSwiglu, pg8::DenseSched>(lds, 1024, 1024, 1024, S, E); } }
            SEAM(pb + 5);
            if (IN(pb + 6)) { PHASE_ENV
                if (l == 2) { pg8::DenseSched S{64, 4, G, c, (const char*)ACT, (const char*)(ws + WS_WDN) + (size_t)1024 * DFF * 2, (size_t)256 * DFF, (size_t)256 * DFF};
                    pg8::EpiFuseT<true> E{(const bf16_t*)XA, (bf16_t*)a->out, H, (const float*)(ws + WS_MODF), a->in[I_FPOSTG] + l * 1024, a->in[I_MPREG] + (l + 1) * 1024, l, l + 1, 5120, 1024, 0,
                                          (f32x4*)(ws + WS_OEX) + (size_t)(2 + (l >> 1)) * 65536, ctl + CW_CNT + (2 + (l >> 1)) * 64, ctl + CW_BAR + XB_TMO, 1, nullptr};
                    pg8::gemm_phase<pg8::EpiFuseT<true>, pg8::DenseSched>(lds, DFF, DFF, DFF, S, E); }
                else { pg8::DenseSched S{64, 4, G, c, (const char*)ACT, (const char*)(ws + WS_WDN) + (size_t)j * 1024 * DFF * 2, (size_t)256 * DFF * 2, (size_t)256 * DFF * 2};
                    pg8::EpiFuse E{(const bf16_t*)XA, (bf16_t*)a->out, H, (const float*)(ws + WS_MODF), a->in[I_FPOSTG] + l * 1024, a->in[I_MPREG] + (l + 1) * 1024, l, l + 1, 5120, 1024, 0,
                                   (f32x4*)(ws + WS_OEX) + (size_t)(2 + (l >> 1)) * 65536, ctl + CW_CNT + (2 + (l >> 1)) * 64, ctl + CW_BAR + XB_TMO, 0, (unsigned char*)(ws + WS_HG8)};
                    pg8::gemm_phase<pg8::EpiFuse, pg8::DenseSched>(lds, DFF, DFF, DFF, S, E); } }
        }
        if (l & 1) SEAM(pb + 6);
        if ((l & 1) && IN(pb + 7)) { PHASE_ENV ThinP P{}; P.xsrc = nullptr; P.xsrcb = (const bf16_t*)XA; P.xdst = l == NLAYER - 1 ? a->out : nullptr; P.xdstb = (bf16_t*)a->out; P.post = (l & 1) ? 2 : 1; P.y = Y; P.oe = OE; P.gpost = a->in[I_FPOSTG] + l * 1024; P.lpost = l; P.gate_off = 5120;
            P.pre = l < NLAYER - 1 ? 1 : 0; P.gpre = a->in[I_MPREG] + (l + 1) * 1024; P.lpre = l + 1; P.sh_off = 0; P.sc_off = 1024; P.H = l == 1 ? nullptr : H; P.H8 = l == 1 ? (unsigned char*)H : nullptr; P.route = 0; P.cnt = ctl + CW_WCNT + j * 2048; P.from_partials = 0;
            thin_phase<true>(lds, a, P); }
        SEAM(pb + 7);
    }
#undef IN
#undef SEAM
}
extern "C" void kernel_launch(void* const* d_in, const int* in_sizes, int n_in, void* d_out, int out_size, void* d_ws, size_t ws_size, hipStream_t stream) {
    static int grid = 0;
    if (grid == 0) {
        if (n_in != 27 || out_size != MTOK * DM || ws_size < WS_END) { fprintf(stderr, "kernel_launch: bad sizes n_in %d out %d ws %zu need %zu\n", n_in, out_size, ws_size, (size_t)WS_END); grid = -1; return; }
        int dev = 0, cus = 0;
        if (hipGetDevice(&dev) != hipSuccess || hipDeviceGetAttribute(&cus, hipDeviceAttributeMultiprocessorCount, dev) != hipSuccess) { grid = -1; return; }
        if (hipFuncSetAttribute((const void*)fwd_kernel, hipFuncAttributeMaxDynamicSharedMemorySize, LDS_BYTES) != hipSuccess) { grid = -1; return; }
        int nb = 0;
        if (hipOccupancyMaxActiveBlocksPerMultiprocessor(&nb, (const void*)fwd_kernel, 512, LDS_BYTES) != hipSuccess || nb < 1) { fprintf(stderr, "kernel_launch: occupancy query %d\n", nb); grid = -1; return; }
        if (cus != 256) { fprintf(stderr, "kernel_launch: %d CUs (the fused row-panel epilogues are laid out for 256 workgroups)\n", cus); grid = -1; return; }
        grid = cus;
    }
    if (grid < 0) return;
    hipMemsetAsync((char*)d_ws + WS_CTL, 0, CTL_BYTES, stream);
    Args a{};
    for (int i = 0; i < 27; ++i) a.in[i] = (const float*)d_in[i];
    a.out = (float*)d_out; a.ws = (unsigned char*)d_ws; a.ph_lo = 0; a.ph_hi = NPHASE; a.dbg = 0; a.pad = 0;
    hipLaunchKernelGGL(fwd_kernel, dim3(grid), dim3(512), LDS_BYTES, stream, a);
}
```

```cpp
#include <hip/hip_runtime.h>
#include <stdint.h>
#include <stdio.h>

#ifndef DBG
#define DBG 0
#endif

#define LAS __attribute__((address_space(3)))
typedef unsigned short bf16_t;
typedef short bf16x8 __attribute__((ext_vector_type(8)));
typedef short s16x4 __attribute__((ext_vector_type(4)));
typedef float f32x2 __attribute__((ext_vector_type(2)));
typedef float f32x4 __attribute__((ext_vector_type(4)));
typedef float f32x16 __attribute__((ext_vector_type(16)));
typedef unsigned u32x2 __attribute__((ext_vector_type(2)));
typedef unsigned u32x4 __attribute__((ext_vector_type(4)));

constexpr int NB = 4, SEQ = 4096, DM = 1024, MTOK = NB * SEQ, NLAYER = 4;
constexpr int IN_SRC = 7696;
constexpr int NIN = 7936;
constexpr int ZP = 7424;
constexpr int ZC_GLU = 0, ZC_SQ = 512, ZC_SK = 1024, ZC_SV = 1536, ZC_GQ = 2048, ZC_GK = 2560, ZC_GV = 3072, ZC_GG = 3584, ZC_GATE = 4096, ZC_GLR = 7168;
constexpr int ABCP = 1536;
constexpr int DFF = 2816, DFFE = 3584, NEXP = 8;
constexpr int MOE_ROWS = 34816;
constexpr float EPS = 1e-6f;
constexpr float LOG2E = 1.4426950408889634f, LN2 = 0.6931471805599453f;

constexpr size_t WS_CTL = 0, CTL_BYTES = 131072;
constexpr size_t WS_MODP = WS_CTL + CTL_BYTES;
constexpr size_t WS_MODF = WS_MODP + (size_t)8 * 98304 * 4;
constexpr size_t WS_DECAY = WS_MODF + (size_t)98304 * 4;
constexpr size_t WS_LIST = WS_DECAY + (size_t)1024 * 128 * 4;
constexpr size_t WS_TOKE = WS_LIST + (size_t)8 * 16384 * 4;
constexpr size_t WS_TOKS = WS_TOKE + (size_t)16384 * 4;
constexpr size_t WS_TOKP = WS_TOKS + (size_t)16384 * 8;
constexpr size_t WS_WIN = WS_TOKP + (size_t)16384 * 8;
constexpr size_t WS_WCAT = WS_WIN + (size_t)4 * NIN * 1024 * 2;
constexpr size_t WS_WO = WS_WCAT + (size_t)4 * 1024 * 1536 * 2;
constexpr size_t WS_WGU = WS_WO + (size_t)4 * 1024 * 1024 * 2;
constexpr size_t WS_WDN = WS_WGU + (size_t)2 * 5632 * 1024 * 2;
constexpr size_t WS_WMGU = WS_WDN + (size_t)2 * 1024 * 2816 * 2;
constexpr size_t WS_WMDN = WS_WMGU + (size_t)16 * 7168 * 1024 * 2;
constexpr size_t WS_R1 = WS_WMDN + (size_t)16 * 1024 * 3584 * 2;
constexpr size_t WS_H = WS_R1 + (size_t)MOE_ROWS * 3584 * 2;
constexpr size_t WS_RY = WS_H + (size_t)MTOK * 1024 * 2;
constexpr size_t WS_RM = WS_RY + (size_t)MOE_ROWS * 1024 * 2;
constexpr size_t WS_MRG = WS_RM + (size_t)MTOK * ABCP * 2;
constexpr size_t WS_OEX = WS_MRG + (size_t)MTOK * 1024 * 2;
constexpr size_t WS_END = WS_OEX + (size_t)4 * 8 * 256 * 1024 * 4;
constexpr size_t WS_HG8 = WS_OEX + (size_t)16 * 1024 * 1024;
constexpr int CW_BAR = 4096;
constexpr int CW_CNT = 8192;
constexpr int CW_WCNT = 28672;

constexpr int RING_BYTES = 131072;
constexpr int MISC_OFF = RING_BYTES;
constexpr int TAB_OFF = MISC_OFF + 64;
constexpr int BASE_OFF = TAB_OFF + 256;
constexpr int GSUM_OFF = BASE_OFF + 8 * 257 * 4;
constexpr int LDS_BYTES = GSUM_OFF + 256;

__device__ __forceinline__ int ltid() { int t = threadIdx.x; asm volatile("" : "+v"(t)); return t; }
__device__ __forceinline__ int lbid() { int t = blockIdx.x; asm volatile("" : "+s"(t)); return t; }
__device__ __forceinline__ int lgrid() { int t = gridDim.x; asm volatile("" : "+s"(t)); return t; }
__device__ __forceinline__ unsigned f2bf(float f) { unsigned u = __builtin_bit_cast(unsigned, f); return (u + 0x7fffu + ((u >> 16) & 1u)) >> 16; }
__device__ __forceinline__ float bf2f(unsigned b) { return __builtin_bit_cast(float, b << 16); }
__device__ __forceinline__ float bflo(unsigned w) { return __builtin_bit_cast(float, w << 16); }
__device__ __forceinline__ float bfhi(unsigned w) { return __builtin_bit_cast(float, w & 0xffff0000u); }
typedef __bf16 bf16x2_t __attribute__((ext_vector_type(2)));
__device__ __forceinline__ unsigned pk2(float lo, float hi) { f32x2 v = {lo, hi}; bf16x2_t b = __builtin_convertvector(v, bf16x2_t); return __builtin_bit_cast(unsigned, b); }
__device__ __forceinline__ float sat8(float x) { return __builtin_amdgcn_fmed3f(x, -448.f, 448.f); }
__device__ __forceinline__ unsigned pk8x4(float a, float b, float c, float d) { return (unsigned)__builtin_amdgcn_cvt_pk_fp8_f32(sat8(c), sat8(d), __builtin_amdgcn_cvt_pk_fp8_f32(sat8(a), sat8(b), 0, false), true); }
__device__ __forceinline__ float ex2(float x) { return __builtin_amdgcn_exp2f(x); }
__device__ __forceinline__ float lg2(float x) { return __builtin_amdgcn_logf(x); }
__device__ __forceinline__ float rcp(float x) { return __builtin_amdgcn_rcpf(x); }
__device__ __forceinline__ float sigm(float x) { return rcp(1.f + ex2(-LOG2E * x)); }
__device__ __forceinline__ float silu(float x) { return x * sigm(x); }
__device__ __forceinline__ float logsig(float u) { return fminf(u, 0.f) - LN2 * lg2(1.f + ex2(-LOG2E * fabsf(u))); }
__device__ __forceinline__ float wave_sum(float v) {
#pragma unroll
    for (int o = 1; o < 64; o <<= 1) v += __shfl_xor(v, o);
    return v;
}
__device__ __forceinline__ int crow(int r, int hi) { return (r & 3) + 8 * (r >> 2) + 4 * hi; }
__device__ __forceinline__ s16x4 trrd(const LAS unsigned char* p) { typedef short v4i16_t __attribute__((ext_vector_type(4))); return __builtin_bit_cast(s16x4, __builtin_amdgcn_ds_read_tr16_b64_v4i16((LAS v4i16_t*)p)); }
__device__ __forceinline__ bf16x8 cat8(s16x4 a, s16x4 b) { return (bf16x8){a[0], a[1], a[2], a[3], b[0], b[1], b[2], b[3]}; }

#define XB_TMO      128
#define XB_XCNT(j)  (256  + 64 * (j))
#define XB_XSUB(j)  (1280 + 64 * (j))
#define XB_XGEN(j)  (2304 + 64 * (j))
#define XB_TOP      3328
#define XB_TOPGEN   3392
#define XCD_BAR_WORDS 3456
#define XB_SPIN_CAP (1u << 18)
__device__ __forceinline__ unsigned xb_ld(unsigned* p)              { return __hip_atomic_load(p, __ATOMIC_RELAXED, __HIP_MEMORY_SCOPE_AGENT); }
__device__ __forceinline__ unsigned xb_add(unsigned* p, unsigned v) { return __hip_atomic_fetch_add(p, v, __ATOMIC_RELAXED, __HIP_MEMORY_SCOPE_AGENT); }
__device__ __forceinline__ unsigned xb_xcc_id() { return (unsigned)__builtin_amdgcn_s_getreg((3 << 11) | 20) & 0xFu; }
#define XB_SPIN(cond, bar) do { unsigned _sp = 0; while (cond) { __builtin_amdgcn_s_sleep(1); \
    if ((++_sp & 255u) == 0u) { if (xb_ld(&(bar)[XB_TMO])) break; if (_sp > XB_SPIN_CAP) { atomicAdd(&(bar)[XB_TMO], 1u); break; } } } } while (0)
struct XcdBarrier { unsigned* bar; unsigned x; volatile LAS unsigned* st; };
__device__ __forceinline__ XcdBarrier xcd_barrier_post(unsigned* bar, volatile LAS unsigned* st) {
    XcdBarrier b; b.bar = bar; b.x = xb_xcc_id(); b.st = st;
    if (threadIdx.x == 0) (void)xb_add(&bar[XB_XCNT(b.x)], 1u);
    return b;
}
__device__ __forceinline__ void xcd_barrier_complete(unsigned* bar, unsigned x, unsigned& nloc, unsigned& nx) {
    const unsigned G = gridDim.x * gridDim.y * gridDim.z;
    unsigned sum, cnt, mine, sp = 0u;
    for (;;) {
        sum = 0u; cnt = 0u; mine = 0u;
#pragma unroll
        for (unsigned j = 0; j < 16; ++j) { const unsigned c = xb_ld(&bar[XB_XCNT(j)]); sum += c; cnt += (c > 0u) ? 1u : 0u; mine = (j == x) ? c : mine; }
        if (sum == G) break;
        __builtin_amdgcn_s_sleep(1);
        if ((++sp & 255u) == 0u) { if (xb_ld(&bar[XB_TMO])) break; if (sp > XB_SPIN_CAP) { atomicAdd(&bar[XB_TMO], 1u); break; } }
    }
    nloc = mine > 0u ? mine : 1u; nx = cnt > 0u ? cnt : 1u;
}
__device__ __forceinline__ void xcd_barrier(const XcdBarrier& b) {
    asm volatile("s_waitcnt vmcnt(0)" ::: "memory");
    __syncthreads();
    if (threadIdx.x == 0) {
        unsigned* bar = b.bar;
        __builtin_amdgcn_s_waitcnt(0);
        unsigned nloc = b.st[0], nx = b.st[1];
        if (nloc == 0u) { xcd_barrier_complete(bar, b.x, nloc, nx); b.st[0] = nloc; b.st[1] = nx; }
        const unsigned old = xb_add(&bar[XB_XSUB(b.x)], 1u);
        const unsigned gen = old / nloc;
        if (old + 1u == (gen + 1u) * nloc) {
            __builtin_amdgcn_fence(__ATOMIC_RELEASE, "agent");
            asm volatile("s_waitcnt vmcnt(0)" ::: "memory");
            const unsigned og = xb_add(&bar[XB_TOP], 1u);
            const unsigned tg = og / nx;
            if (og + 1u == (tg + 1u) * nx) xb_add(&bar[XB_TOPGEN], 1u);
            else XB_SPIN(xb_ld(&bar[XB_TOPGEN]) == tg, bar);
            __builtin_amdgcn_fence(__ATOMIC_ACQUIRE, "agent");
            xb_add(&bar[XB_XGEN(b.x)], 1u);
            asm volatile("s_waitcnt vmcnt(0)" ::: "memory");
        } else {
            XB_SPIN(xb_ld(&bar[XB_XGEN(b.x)]) == gen, bar);
            __builtin_amdgcn_fence(__ATOMIC_ACQUIRE, "agent");
            asm volatile("s_waitcnt vmcnt(0)" ::: "memory");
        }
    }
    __syncthreads();
}
namespace pg8 {
constexpr int BM = 256, BK = 64, HALF = 128, HTB = HALF * BK * 2, STAGE_BYTES = 8 * HTB, NXCD = 8, WGM = 8;
__host__ __device__ __forceinline__ int lds_byte(int r, int c) { const int st = (r >> 4) * 2 + (c >> 5), rr = r & 15, cc = c & 31, ob = rr * 64 + cc * 2; return st * 1024 + (ob ^ (((ob >> 9) & 1) << 5)); }
__host__ __device__ __forceinline__ void stage_rc(int b, int& R, int& C) { const int st = b / 1024, sb = b % 1024, swz = sb ^ (((sb >> 9) & 1) << 5); R = (st >> 1) * 16 + swz / 64; C = (st & 1) * 32 + (swz % 64) / 2; }
__host__ __device__ __forceinline__ int perm32(int rho) { const int n = rho >> 4, i = rho & 15; return 8 * (i >> 2) + 4 * n + (i & 3); }

struct Unit { int pm, pn, e, rt; };

__device__ __forceinline__ bool tile_of(long L, int nM, int nN, int& pm, int& pn) {
    const int nwg = nM * nN; if (L >= nwg) return false;
    int wgid = (int)L; { const int q = nwg / NXCD, r = nwg % NXCD, xcd = wgid % NXCD, off = wgid / NXCD; wgid = (xcd < r ? xcd * (q + 1) : r * (q + 1) + (xcd - r) * q) + off; }
    const int nig = WGM * nN, gid = wgid / nig, fm = gid * WGM, gsz = (nM - fm) < WGM ? (nM - fm) : WGM;
    pm = fm + ((wgid % nig) % gsz); pn = (wgid % nig) / gsz; return true;
}
struct DenseSched {
    static constexpr bool GATHER = false;
    int nM, nN, G, c; const char* A; const char* Bt; size_t tA, tB;
    __device__ __forceinline__ bool next(int i, Unit& u) const { u.e = 0; u.rt = 0; return tile_of((long)i * G + c, nM, nN, u.pm, u.pn); }
    __device__ __forceinline__ const char* a_ptr(const Unit& u) const { return A + (size_t)u.pm * tA; }
    __device__ __forceinline__ const char* b_ptr(const Unit& u) const { return Bt + (size_t)u.pn * tB; }
    __device__ __forceinline__ unsigned row_tok(const Unit&, int) const { return 0u; }
};
struct InSched {
    static constexpr bool GATHER = false;
    int G, c; const char* A; const char* Bt; size_t tA, tB; int lo, hi;
    __device__ __forceinline__ bool next(int i, Unit& u) const { const int L = lo + i * G + c; u.e = 0; u.rt = 0; if (L >= hi) return false;
        const int ci = L >> 6; u.pm = L & 63; u.pn = ci < 12 ? 18 + ci : ci < 16 ? ci - 12 : ci < 18 ? ci : ci < 30 ? ci - 14 : 30; return true; }
    __device__ __forceinline__ const char* a_ptr(const Unit& u) const { return A + (size_t)u.pm * tA; }
    __device__ __forceinline__ const char* b_ptr(const Unit& u) const { return Bt + (size_t)u.pn * tB; }
    __device__ __forceinline__ unsigned row_tok(const Unit&, int) const { return 0u; }
};
struct CatSched {
    static constexpr bool GATHER = false;
    int G, c; const char* A; const char* Bt; size_t tA, tB;
    __device__ __forceinline__ bool next(int i, Unit& u) const { u.e = i % 3; u.rt = 0; return tile_of((long)(i / 3) * G + c, 64, 4, u.pm, u.pn); }
    __device__ __forceinline__ const char* a_ptr(const Unit& u) const { return A + (size_t)u.pm * tA + (size_t)u.e * 1024; }
    __device__ __forceinline__ const char* b_ptr(const Unit& u) const { return Bt + (size_t)u.pn * tB + (size_t)u.e * 1024; }
    __device__ __forceinline__ unsigned row_tok(const Unit&, int) const { return 0u; }
};
template <bool GATH> struct MoeSched {
    static constexpr bool GATHER = GATH;
    int nN, G, c; const LAS int* tab; const char* A; const char* Bt; size_t tA, tB, eB; const int* list; unsigned rowbytes; int cap;
    __device__ __forceinline__ bool next(int i, Unit& u) const {
        const int nM = tab[8] < cap ? tab[8] : cap; int pmg, pn; if (!tile_of((long)i * G + c, nM, nN, pmg, pn)) return false;
        int e = 0;
#pragma unroll
        for (int j = 1; j < 8; ++j) e += (pmg >= tab[j]) ? 1 : 0;
        u.pm = pmg; u.pn = pn; u.e = e; u.rt = pmg - tab[e]; return true;
    }
    __device__ __forceinline__ const char* a_ptr(const Unit& u) const { return GATH ? A : A + (size_t)u.pm * tA; }
    __device__ __forceinline__ const char* b_ptr(const Unit& u) const { return Bt + (size_t)u.e * eB + (size_t)u.pn * tB; }
    __device__ __forceinline__ unsigned row_tok(const Unit& u, int r) const { const int slot = u.rt * 256 + r; if (slot >= tab[16 + u.e]) return 0u;
        const LAS int* B = (const LAS int*)((const LAS unsigned char*)tab + (BASE_OFF - TAB_OFF)) + u.e * 257; int lo = 0;
#pragma unroll
        for (int st = 128; st >= 1; st >>= 1) lo += (B[lo + st] <= slot) ? st : 0;
        return (unsigned)list[(lo * 8 + u.e) * 64 + (slot - B[lo])]; }
};

struct MoeTailSched {
    static constexpr bool GATHER = false; static constexpr int SK = 2, KS = 1792;
    int G, c; const LAS int* tab; const char* A; const char* Bt; size_t tA, tB, eB;
    __device__ __forceinline__ bool next(int i, Unit& u) const {
        const int nx = tab[8] - 128; const long L = (long)i * G + c; if (L >= (long)nx * 4 * SK) return false;
        const int part = (int)(L % SK), rest = (int)(L / SK), pn = rest & 3, pmx = rest >> 2, pmg = 128 + pmx;
        int e = 0;
#pragma unroll
        for (int j = 1; j < 8; ++j) e += (pmg >= tab[j]) ? 1 : 0;
        u.pm = part * 8 + pmx; u.pn = pn; u.e = e; u.rt = pmx * SK + part; return true;
    }
    __device__ __forceinline__ const char* a_ptr(const Unit& u) const { return A + (size_t)(128 + u.rt / SK) * tA + (size_t)(u.rt % SK) * KS; }
    __device__ __forceinline__ const char* b_ptr(const Unit& u) const { return Bt + (size_t)u.e * eB + (size_t)u.pn * tB + (size_t)(u.rt % SK) * KS; }
    __device__ __forceinline__ unsigned row_tok(const Unit&, int) const { return 0u; }
};

struct EpiF32 {
    static constexpr bool PERM = false; static constexpr bool AFTER_DRAIN = false; static constexpr bool F8 = false;
    float* C; int ldc;
    __device__ __forceinline__ void operator()(const f32x4 (&acc)[2][2][4][2], const Unit& u, int wr, int wc, int fr, int fq) const {
        const int row0 = u.pm * BM + wr * 64 + fr, col0 = u.pn * BM + wc * 32 + 4 * fq;
#pragma unroll
        for (int ai = 0; ai < 2; ++ai)
#pragma unroll
            for (int m = 0; m < 4; ++m) { float* rowp = C + (size_t)(row0 + ai * HALF + m * 16) * ldc + col0;
#pragma unroll
                for (int bj = 0; bj < 2; ++bj)
#pragma unroll
                    for (int n = 0; n < 2; ++n) *(f32x4*)(rowp + bj * HALF + n * 16) = acc[ai][bj][m][n]; }
    }
};
struct EpiF32F8 {
    static constexpr bool PERM = false; static constexpr bool AFTER_DRAIN = false; static constexpr bool F8 = true;
    float* C; int ldc;
    __device__ __forceinline__ void operator()(const f32x4 (&acc)[2][2][4][2], const Unit& u, int wr, int wc, int fr, int fq) const {
        const int row0 = u.pm * BM + wr * 64 + fr, col0 = u.pn * BM + wc * 32 + 4 * fq;
#pragma unroll
        for (int ai = 0; ai < 2; ++ai)
#pragma unroll
            for (int m = 0; m < 4; ++m) { float* rowp = C + (size_t)(row0 + ai * HALF + m * 16) * ldc + col0;
#pragma unroll
                for (int bj = 0; bj < 2; ++bj)
#pragma unroll
                    for (int n = 0; n < 2; ++n) *(f32x4*)(rowp + bj * HALF + n * 16) = acc[ai][bj][m][n]; }
    }
};
struct EpiBf16 {
    static constexpr bool PERM = true; static constexpr bool AFTER_DRAIN = false; static constexpr bool F8 = false;
    bf16_t* O; int ldc;
    __device__ __forceinline__ void operator()(const f32x4 (&acc)[2][2][4][2], const Unit& u, int wr, int wc, int fr, int fq) const {
        const int row0 = u.pm * BM + wr * 64 + fr, col0 = u.pn * BM + wc * 32 + 8 * fq;
#pragma unroll
        for (int ai = 0; ai < 2; ++ai)
#pragma unroll
            for (int m = 0; m < 4; ++m) { bf16_t* rowp = O + (size_t)(row0 + ai * HALF + m * 16) * ldc + col0;
#pragma unroll
                for (int bj = 0; bj < 2; ++bj) { const f32x4 v0 = acc[ai][bj][m][0], v1 = acc[ai][bj][m][1];
                    u32x4 w; w.x = pk2(v0[0], v0[1]); w.y = pk2(v0[2], v0[3]); w.z = pk2(v1[0], v1[1]); w.w = pk2(v1[2], v1[3]);
                    *(u32x4*)(rowp + bj * HALF) = w; } }
    }
};
struct EpiBf16F8 {
    static constexpr bool PERM = true; static constexpr bool AFTER_DRAIN = false; static constexpr bool F8 = true;
    bf16_t* O; int ldc;
    __device__ __forceinline__ void operator()(const f32x4 (&acc)[2][2][4][2], const Unit& u, int wr, int wc, int fr, int fq) const {
        const int row0 = u.pm * BM + wr * 64 + fr, col0 = u.pn * BM + wc * 32 + 8 * fq;
#pragma unroll
        for (int ai = 0; ai < 2; ++ai)
#pragma unroll
            for (int m = 0; m < 4; ++m) { bf16_t* rowp = O + (size_t)(row0 + ai * HALF + m * 16) * ldc + col0;
#pragma unroll
                for (int bj = 0; bj < 2; ++bj) { const f32x4 v0 = acc[ai][bj][m][0], v1 = acc[ai][bj][m][1];
                    u32x4 w; w.x = pk2(v0[0], v0[1]); w.y = pk2(v0[2], v0[3]); w.z = pk2(v1[0], v1[1]); w.w = pk2(v1[2], v1[3]);
                    *(u32x4*)(rowp + bj * HALF) = w; } }
    }
};
struct EpiIn {
    static constexpr bool PERM = true; static constexpr bool AFTER_DRAIN = false; static constexpr bool F8 = false;
    bf16_t* Z;
    __device__ __forceinline__ void operator()(const f32x4 (&acc)[2][2][4][2], const Unit& u, int wr, int wc, int fr, int fq) const {
        const int row0 = u.pm * BM + wr * 64 + fr, c0 = u.pn * BM + wc * 32 + 8 * fq;
        if (u.pn < 4) {
#pragma unroll
            for (int ai = 0; ai < 2; ++ai)
#pragma unroll
                for (int m = 0; m < 4; ++m) { bf16_t* rowp = Z + (size_t)(row0 + ai * HALF + m * 16) * ZP + u.pn * HALF + wc * 32 + 8 * fq;
                    const f32x4 a0 = acc[ai][0][m][0], a1 = acc[ai][0][m][1], g0 = acc[ai][1][m][0], g1 = acc[ai][1][m][1];
                    u32x4 w; w.x = pk2(a0[0] * sigm(g0[0]), a0[1] * sigm(g0[1])); w.y = pk2(a0[2] * sigm(g0[2]), a0[3] * sigm(g0[3]));
                    w.z = pk2(a1[0] * sigm(g1[0]), a1[1] * sigm(g1[1])); w.w = pk2(a1[2] * sigm(g1[2]), a1[3] * sigm(g1[3]));
                    *(u32x4*)rowp = w; }
        } else {
            int act = 0;
            if (u.pn == 16 || u.pn == 17) act = 1; else if (u.pn >= 18 && u.pn < 30) act = 2;
#pragma unroll
            for (int ai = 0; ai < 2; ++ai)
#pragma unroll
                for (int m = 0; m < 4; ++m) { bf16_t* rowp = Z + (size_t)(row0 + ai * HALF + m * 16) * ZP + (c0 - 512);
#pragma unroll
                    for (int bj = 0; bj < 2; ++bj) { f32x4 v0 = acc[ai][bj][m][0], v1 = acc[ai][bj][m][1];
                        if (act == 1) {
#pragma unroll
                            for (int j = 0; j < 4; ++j) { v0[j] = silu(v0[j]); v1[j] = silu(v1[j]); } }
                        else if (act == 2) {
#pragma unroll
                            for (int j = 0; j < 4; ++j) { v0[j] = sigm(v0[j]); v1[j] = sigm(v1[j]); } }
                        u32x4 w; w.x = pk2(v0[0], v0[1]); w.y = pk2(v0[2], v0[3]); w.z = pk2(v1[0], v1[1]); w.w = pk2(v1[2], v1[3]);
                        *(u32x4*)(rowp + bj * HALF) = w; } }
        }
    }
};
struct EpiInF8 {
    static constexpr bool PERM = true; static constexpr bool AFTER_DRAIN = false; static constexpr bool F8 = true;
    bf16_t* Z;
    __device__ __forceinline__ void operator()(const f32x4 (&acc)[2][2][4][2], const Unit& u, int wr, int wc, int fr, int fq) const {
        const int row0 = u.pm * BM + wr * 64 + fr, c0 = u.pn * BM + wc * 32 + 8 * fq;
        if (u.pn < 4) {
#pragma unroll
            for (int ai = 0; ai < 2; ++ai)
#pragma unroll
                for (int m = 0; m < 4; ++m) { bf16_t* rowp = Z + (size_t)(row0 + ai * HALF + m * 16) * ZP + u.pn * HALF + wc * 32 + 8 * fq;
                    const f32x4 a0 = acc[ai][0][m][0], a1 = acc[ai][0][m][1], g0 = acc[ai][1][m][0], g1 = acc[ai][1][m][1];
                    u32x4 w; w.x = pk2(a0[0] * sigm(g0[0]), a0[1] * sigm(g0[1])); w.y = pk2(a0[2] * sigm(g0[2]), a0[3] * sigm(g0[3]));
                    w.z = pk2(a1[0] * sigm(g1[0]), a1[1] * sigm(g1[1])); w.w = pk2(a1[2] * sigm(g1[2]), a1[3] * sigm(g1[3]));
                    *(u32x4*)rowp = w; }
        } else {
            int act = 0;
            if (u.pn == 16 || u.pn == 17) act = 1; else if (u.pn >= 18 && u.pn < 30) act = 2;
#pragma unroll
            for (int ai = 0; ai < 2; ++ai)
#pragma unroll
                for (int m = 0; m < 4; ++m) { bf16_t* rowp = Z + (size_t)(row0 + ai * HALF + m * 16) * ZP + (c0 - 512);
#pragma unroll
                    for (int bj = 0; bj < 2; ++bj) { f32x4 v0 = acc[ai][bj][m][0], v1 = acc[ai][bj][m][1];
                        if (act == 1) {
#pragma unroll
                            for (int j = 0; j < 4; ++j) { v0[j] = silu(v0[j]); v1[j] = silu(v1[j]); } }
                        else if (act == 2) {
#pragma unroll
                            for (int j = 0; j < 4; ++j) { v0[j] = sigm(v0[j]); v1[j] = sigm(v1[j]); } }
                        u32x4 w; w.x = pk2(v0[0], v0[1]); w.y = pk2(v0[2], v0[3]); w.z = pk2(v1[0], v1[1]); w.w = pk2(v1[2], v1[3]);
                        *(u32x4*)(rowp + bj * HALF) = w; } }
        }
    }
};
struct EpiMerge {
    static constexpr bool PERM = true; static constexpr bool AFTER_DRAIN = false; static constexpr bool F8 = false;
    const bf16_t* Zg0; bf16_t* MRG;
    __device__ __forceinline__ void operator()(const f32x4 (&acc)[2][2][4][2], const Unit& u, int wr, int wc, int fr, int fq) const {
        const int row0 = u.pm * BM + wr * 64 + fr, c0 = u.pn * BM + wc * 32 + 8 * fq; const bf16_t* Zg = Zg0 + 1024 * u.e; const int accum = u.e;
#pragma unroll
        for (int ai = 0; ai < 2; ++ai) { u32x4 g[4][2], p[4][2];
#pragma unroll
            for (int m = 0; m < 4; ++m)
#pragma unroll
                for (int bj = 0; bj < 2; ++bj) g[m][bj] = *(const u32x4*)(Zg + (size_t)(row0 + ai * HALF + m * 16) * ZP + c0 + bj * HALF);
            if (accum) {
#pragma unroll
                for (int m = 0; m < 4; ++m)
#pragma unroll
                    for (int bj = 0; bj < 2; ++bj) p[m][bj] = *(const u32x4*)(MRG + (size_t)(row0 + ai * HALF + m * 16) * 1024 + c0 + bj * HALF);
            } else {
#pragma unroll
                for (int m = 0; m < 4; ++m)
#pragma unroll
                    for (int bj = 0; bj < 2; ++bj) p[m][bj] = (u32x4){0u, 0u, 0u, 0u};
            }
#pragma unroll
            for (int m = 0; m < 4; ++m)
#pragma unroll
                for (int bj = 0; bj < 2; ++bj) { const f32x4 v0 = acc[ai][bj][m][0], v1 = acc[ai][bj][m][1]; const u32x4 gg = g[m][bj], pp = p[m][bj];
                    u32x4 w;
                    w.x = pk2(bflo(pp.x) + bflo(gg.x) * v0[0], bfhi(pp.x) + bfhi(gg.x) * v0[1]); w.y = pk2(bflo(pp.y) + bflo(gg.y) * v0[2], bfhi(pp.y) + bfhi(gg.y) * v0[3]);
                    w.z = pk2(bflo(pp.z) + bflo(gg.z) * v1[0], bfhi(pp.z) + bfhi(gg.z) * v1[1]); w.w = pk2(bflo(pp.w) + bflo(gg.w) * v1[2], bfhi(pp.w) + bfhi(gg.w) * v1[3]);
                    *(u32x4*)(MRG + (size_t)(row0 + ai * HALF + m * 16) * 1024 + c0 + bj * HALF) = w; } }
    }
};
typedef unsigned short u16x2v __attribute__((ext_vector_type(2)));
__device__ __forceinline__ unsigned pkmax16(unsigned w) { const u16x2v a = __builtin_bit_cast(u16x2v, w), f = {0x2180, 0x2180};
    return __builtin_bit_cast(unsigned, __builtin_elementwise_max(a, f)); }
struct EpiMergeR {
    static constexpr bool PERM = true; static constexpr bool AFTER_DRAIN = false; static constexpr bool F8 = false;
    const bf16_t* Zg0; bf16_t* MRG;
    __device__ __forceinline__ void operator()(const f32x4 (&)[2][2][4][2], const Unit&, int, int, int, int) const {}
    __device__ __forceinline__ bool clear_after(const Unit& u) const { return u.e == 2; }
    __device__ __forceinline__ void inplace(f32x4 (&acc)[2][2][4][2], const Unit& u, int wr, int wc, int fr, int fq) const {
        const int row0 = u.pm * BM + wr * 64 + fr, c0 = u.pn * BM + wc * 32 + 8 * fq; const bf16_t* Zg = Zg0 + 1024 * u.e; const float GE = 8.673617379884035e-19f;
        if (u.e < 2) {
#pragma unroll
            for (int ai = 0; ai < 2; ++ai) { u32x4 g[4][2], gn[4][2];
#pragma unroll
                for (int m = 0; m < 4; ++m)
#pragma unroll
                    for (int bj = 0; bj < 2; ++bj) { const bf16_t* q = Zg + (size_t)(row0 + ai * HALF + m * 16) * ZP + c0 + bj * HALF; g[m][bj] = *(const u32x4*)q; gn[m][bj] = *(const u32x4*)(q + 1024); }
#pragma unroll
                for (int m = 0; m < 4; ++m)
#pragma unroll
                    for (int bj = 0; bj < 2; ++bj) { const u32x4 a = g[m][bj], d = gn[m][bj];
                        const unsigned aw[4] = {a.x, a.y, a.z, a.w}, dw[4] = {d.x, d.y, d.z, d.w};
#pragma unroll
                        for (int n = 0; n < 2; ++n)
#pragma unroll
                            for (int q = 0; q < 4; ++q) { const unsigned wa = pkmax16(aw[n * 2 + (q >> 1)]), wd = pkmax16(dw[n * 2 + (q >> 1)]);
                                const float ga = (q & 1) ? bfhi(wa) : bflo(wa), gd = (q & 1) ? bfhi(wd) : bflo(wd);
                                acc[ai][bj][m][n][q] *= ga * rcp(gd); } } }
        } else {
#pragma unroll
            for (int ai = 0; ai < 2; ++ai) { u32x4 g[4][2];
#pragma unroll
                for (int m = 0; m < 4; ++m)
#pragma unroll
                    for (int bj = 0; bj < 2; ++bj) g[m][bj] = *(const u32x4*)(Zg + (size_t)(row0 + ai * HALF + m * 16) * ZP + c0 + bj * HALF);
#pragma unroll
                for (int m = 0; m < 4; ++m)
#pragma unroll
                    for (int bj = 0; bj < 2; ++bj) { const f32x4 v0 = acc[ai][bj][m][0], v1 = acc[ai][bj][m][1]; const u32x4 gg = g[m][bj];
                        u32x4 w;
                        w.x = pk2(fmaxf(bflo(gg.x), GE) * v0[0], fmaxf(bfhi(gg.x), GE) * v0[1]); w.y = pk2(fmaxf(bflo(gg.y), GE) * v0[2], fmaxf(bfhi(gg.y), GE) * v0[3]);
                        w.z = pk2(fmaxf(bflo(gg.z), GE) * v1[0], fmaxf(bfhi(gg.z), GE) * v1[1]); w.w = pk2(fmaxf(bflo(gg.w), GE) * v1[2], fmaxf(bfhi(gg.w), GE) * v1[3]);
                        *(u32x4*)(MRG + (size_t)(row0 + ai * HALF + m * 16) * 1024 + c0 + bj * HALF) = w; } }
        }
    }
};
template <class E> struct epi_inplace { static constexpr bool v = false; };
template <> struct epi_inplace<EpiMergeR> { static constexpr bool v = true; };
struct EpiSwiglu {
    static constexpr bool PERM = true; static constexpr bool AFTER_DRAIN = false; static constexpr bool F8 = false;
    bf16_t* ACT; int ldc;
    __device__ __forceinline__ void operator()(const f32x4 (&acc)[2][2][4][2], const Unit& u, int wr, int wc, int fr, int fq) const {
        const int row0 = u.pm * BM + wr * 64 + fr, c0 = u.pn * HALF + wc * 32 + 8 * fq;
#pragma unroll
        for (int ai = 0; ai < 2; ++ai)
#pragma unroll
            for (int m = 0; m < 4; ++m) { bf16_t* rowp = ACT + (size_t)(row0 + ai * HALF + m * 16) * ldc + c0;
                const f32x4 g0 = acc[ai][0][m][0], g1 = acc[ai][0][m][1], u0 = acc[ai][1][m][0], u1 = acc[ai][1][m][1];
                u32x4 w; w.x = pk2(silu(g0[0]) * u0[0], silu(g0[1]) * u0[1]); w.y = pk2(silu(g0[2]) * u0[2], silu(g0[3]) * u0[3]);
                w.z = pk2(silu(g1[0]) * u1[0], silu(g1[1]) * u1[1]); w.w = pk2(silu(g1[2]) * u1[2], silu(g1[3]) * u1[3]);
                *(u32x4*)rowp = w; }
    }
};
struct EpiSwigluF8b {
    static constexpr bool PERM = true; static constexpr bool AFTER_DRAIN = false; static constexpr bool F8 = true;
    bf16_t* ACT; int ldc;
    __device__ __forceinline__ void operator()(const f32x4 (&acc)[2][2][4][2], const Unit& u, int wr, int wc, int fr, int fq) const {
        const int row0 = u.pm * BM + wr * 64 + fr, c0 = u.pn * HALF + wc * 32 + 8 * fq;
#pragma unroll
        for (int ai = 0; ai < 2; ++ai)
#pragma unroll
            for (int m = 0; m < 4; ++m) { bf16_t* rowp = ACT + (size_t)(row0 + ai * HALF + m * 16) * ldc + c0;
                const f32x4 g0 = acc[ai][0][m][0], g1 = acc[ai][0][m][1], u0 = acc[ai][1][m][0], u1 = acc[ai][1][m][1];
                u32x4 w; w.x = pk2(silu(g0[0]) * u0[0], silu(g0[1]) * u0[1]); w.y = pk2(silu(g0[2]) * u0[2], silu(g0[3]) * u0[3]);
                w.z = pk2(silu(g1[0]) * u1[0], silu(g1[1]) * u1[1]); w.w = pk2(silu(g1[2]) * u1[2], silu(g1[3]) * u1[3]);
                *(u32x4*)rowp = w; }
    }
};
struct EpiSwigluF8 {
    static constexpr bool PERM = true; static constexpr bool AFTER_DRAIN = false; static constexpr bool F8 = true;
    bf16_t* ACT; int ldc;
    __device__ __forceinline__ void operator()(const f32x4 (&acc)[2][2][4][2], const Unit& u, int wr, int wc, int fr, int fq) const {
        const int row0 = u.pm * BM + wr * 64 + fr, c0 = u.pn * HALF + wc * 32 + 8 * fq;
#pragma unroll
        for (int ai = 0; ai < 2; ++ai)
#pragma unroll
            for (int m = 0; m < 4; ++m) { unsigned char* rowp = (unsigned char*)ACT + (size_t)(row0 + ai * HALF + m * 16) * ldc + c0;
                const f32x4 g0 = acc[ai][0][m][0], g1 = acc[ai][0][m][1], u0 = acc[ai][1][m][0], u1 = acc[ai][1][m][1];
                const float o0 = silu(g0[0]) * u0[0], o1 = silu(g0[1]) * u0[1], o2 = silu(g0[2]) * u0[2], o3 = silu(g0[3]) * u0[3], o4 = silu(g1[0]) * u1[0], o5 = silu(g1[1]) * u1[1], o6 = silu(g1[2]) * u1[2], o7 = silu(g1[3]) * u1[3];
                u32x2 w; w.x = pk8x4(o0, o1, o2, o3); w.y = pk8x4(o4, o5, o6, o7);
                *(u32x2*)rowp = w; }
    }
};
template <bool F8V> struct EpiFuseT {
    static constexpr bool PERM = true; static constexpr bool AFTER_DRAIN = true; static constexpr bool F8 = F8V;
    const bf16_t* xs; bf16_t* xd; bf16_t* H; const float* mf; const float* gpost; const float* gpre; int lpost, lpre, gate_off, sc_off, sh_off;
    f32x4* slots; unsigned* cnt; unsigned* tmo; int h8; unsigned char* H8x;
    __device__ __forceinline__ void operator()(const f32x4 (&)[2][2][4][2], const Unit&, int, int, int, int) const {}
    __device__ __forceinline__ void fused(f32x4 (&acc)[2][2][4][2], const Unit& u, int wr, int wc, int fr, int fq, LAS unsigned char* lds) const {
        const int tid = ltid(); const int b = u.pm >> 4, c0 = u.pn * BM + wc * 32 + 8 * fq;
        LAS f32x4* P = (LAS f32x4*)lds;
        LAS float* RR = (LAS float*)(lds + 16384);
        f32x4* sp = slots + (size_t)u.pm * 1024;
        { f32x4 Gv[2][2]; const float* mg = mf + (size_t)(lpost * 4 + b) * 6144 + gate_off;
#pragma unroll
          for (int bj = 0; bj < 2; ++bj)
#pragma unroll
              for (int n = 0; n < 2; ++n) Gv[bj][n] = *(const f32x4*)(mg + c0 + bj * HALF + n * 4) * *(const f32x4*)(gpost + c0 + bj * HALF + n * 4);
#pragma unroll
          for (int ai = 0; ai < 2; ++ai) { u32x4 xq[4][2];
#pragma unroll
              for (int m = 0; m < 4; ++m)
#pragma unroll
                  for (int bj = 0; bj < 2; ++bj) xq[m][bj] = *(const u32x4*)(xs + ((size_t)u.pm * BM + wr * 64 + fr + ai * HALF + m * 16) * 1024 + c0 + bj * HALF);
#pragma unroll
              for (int m = 0; m < 4; ++m) { const int rloc = wr * 64 + fr + ai * HALF + m * 16;
                  float s0 = 0.f, s1 = 0.f, s2 = 0.f, s3 = 0.f;
#pragma unroll
                  for (int bj = 0; bj < 2; ++bj) { const u32x4 xv = xq[m][bj];
                      const float xf[8] = {bflo(xv.x), bfhi(xv.x), bflo(xv.y), bfhi(xv.y), bflo(xv.z), bfhi(xv.z), bflo(xv.w), bfhi(xv.w)};
#pragma unroll
                      for (int n = 0; n < 2; ++n)
#pragma unroll
                          for (int q = 0; q < 4; ++q) { const float y = acc[ai][bj][m][n][q], gy = Gv[bj][n][q] * y, x = xf[n * 4 + q]; acc[ai][bj][m][n][q] = gy;
                              s0 += y * y; s1 += x * x; s2 += x * gy; s3 += gy * gy; } }
                  s0 += __shfl_xor(s0, 16); s1 += __shfl_xor(s1, 16); s2 += __shfl_xor(s2, 16); s3 += __shfl_xor(s3, 16);
                  s0 += __shfl_xor(s0, 32); s1 += __shfl_xor(s1, 32); s2 += __shfl_xor(s2, 32); s3 += __shfl_xor(s3, 32);
                  if (fq == 0) P[wc * 256 + rloc] = (f32x4){s0, s1, s2, s3}; } } }
        f32x4 Av[2][2], Bv[2][2]; { const float* ms = mf + (size_t)(lpre * 4 + b) * 6144;
#pragma unroll
          for (int bj = 0; bj < 2; ++bj)
#pragma unroll
              for (int n = 0; n < 2; ++n) { const int c = c0 + bj * HALF + n * 4; Av[bj][n] = *(const f32x4*)(gpre + c) * (*(const f32x4*)(ms + sc_off + c) + 1.f); Bv[bj][n] = *(const f32x4*)(ms + sh_off + c); } }
        __syncthreads();
        if (tid < 256) { const f32x4 S = (P[tid] + P[256 + tid]) + (P[512 + tid] + P[768 + tid]);
            asm volatile("global_store_dwordx4 %0, %1, off sc1\n\ts_nop 1" :: "v"(sp + u.pn * 256 + tid), "v"(S) : "memory"); }
        asm volatile("s_waitcnt vmcnt(0)" ::: "memory");
        __syncthreads();
        if (tid == 0) { unsigned* w = cnt + u.pm; __hip_atomic_fetch_add(w, 1u, __ATOMIC_RELAXED, __HIP_MEMORY_SCOPE_AGENT); unsigned spn = 0;
            while (__hip_atomic_load(w, __ATOMIC_RELAXED, __HIP_MEMORY_SCOPE_AGENT) < 4u) { __builtin_amdgcn_s_sleep(2);
                if ((++spn & 255u) == 0u) { if (__hip_atomic_load(tmo, __ATOMIC_RELAXED, __HIP_MEMORY_SCOPE_AGENT) != 0u) break; if (spn > (1u << 22)) { __hip_atomic_store(tmo, 1u, __ATOMIC_RELAXED, __HIP_MEMORY_SCOPE_AGENT); break; } } }
            __builtin_amdgcn_fence(__ATOMIC_ACQUIRE, "agent"); asm volatile("s_waitcnt vmcnt(0)" ::: "memory"); }
        __syncthreads();
        if (tid < 256) { const f32x4 T = (sp[tid] + sp[256 + tid]) + (sp[512 + tid] + sp[768 + tid]);
            const float r = 1.0f / sqrtf(T[0] * (1.f / 1024.f) + EPS); const float ssm = T[1] + 2.f * r * T[2] + r * r * T[3];
            RR[tid * 2] = r; RR[tid * 2 + 1] = 1.0f / sqrtf(fmaxf(ssm, 0.f) * (1.f / 1024.f) + EPS); }
        __syncthreads();
        {
#pragma unroll
          for (int ai = 0; ai < 2; ++ai) { u32x4 xq[4][2];
#pragma unroll
              for (int m = 0; m < 4; ++m)
#pragma unroll
                  for (int bj = 0; bj < 2; ++bj) xq[m][bj] = *(const u32x4*)(xs + ((size_t)u.pm * BM + wr * 64 + fr + ai * HALF + m * 16) * 1024 + c0 + bj * HALF);
#pragma unroll
              for (int m = 0; m < 4; ++m) { const int rloc = wr * 64 + fr + ai * HALF + m * 16; const size_t row = (size_t)u.pm * BM + rloc; const float r = RR[rloc * 2], r2 = RR[rloc * 2 + 1];
#pragma unroll
                  for (int bj = 0; bj < 2; ++bj) { const u32x4 xv = xq[m][bj];
                      const float xf[8] = {bflo(xv.x), bfhi(xv.x), bflo(xv.y), bfhi(xv.y), bflo(xv.z), bfhi(xv.z), bflo(xv.w), bfhi(xv.w)};
                      float xm[8], hv[8];
#pragma unroll
                      for (int n = 0; n < 2; ++n)
#pragma unroll
                          for (int q = 0; q < 4; ++q) { xm[n * 4 + q] = xf[n * 4 + q] + r * acc[ai][bj][m][n][q]; hv[n * 4 + q] = (xm[n * 4 + q] * r2) * Av[bj][n][q] + Bv[bj][n][q]; }
                      u32x4 wx, wh; wx.x = pk2(xm[0], xm[1]); wx.y = pk2(xm[2], xm[3]); wx.z = pk2(xm[4], xm[5]); wx.w = pk2(xm[6], xm[7]);
                      wh.x = pk2(hv[0], hv[1]); wh.y = pk2(hv[2], hv[3]); wh.z = pk2(hv[4], hv[5]); wh.w = pk2(hv[6], hv[7]);
                      *(u32x4*)(xd + row * 1024 + c0 + bj * HALF) = wx;
                      if (h8) { u32x2 w8; w8.x = pk8x4(hv[0], hv[1], hv[2], hv[3]);
                          w8.y = pk8x4(hv[4], hv[5], hv[6], hv[7]);
                          *(u32x2*)((unsigned char*)H + row * 1024 + c0 + bj * HALF) = w8; }
                      else { *(u32x4*)(H + row * 1024 + c0 + bj * HALF) = wh;
                          if (H8x) { u32x2 w8; w8.x = pk8x4(hv[0], hv[1], hv[2], hv[3]); w8.y = pk8x4(hv[4], hv[5], hv[6], hv[7]); *(u32x2*)(H8x + row * 1024 + c0 + bj * HALF) = w8; } } } } } }
        __syncthreads();
    }
};
typedef EpiFuseT<false> EpiFuse;

typedef int v8i32 __attribute__((ext_vector_type(8)));
__device__ __forceinline__ v8i32 cat32(bf16x8 lo, bf16x8 hi) { typedef int v4i __attribute__((ext_vector_type(4))); const v4i a = __builtin_bit_cast(v4i, lo), b = __builtin_bit_cast(v4i, hi); return (v8i32){a[0], a[1], a[2], a[3], b[0], b[1], b[2], b[3]}; }
__device__ __forceinline__ void mfma_f8(f32x4& c, v8i32 a, v8i32 b, int sc) { asm volatile("v_mfma_scale_f32_16x16x128_f8f6f4 %0, %1, %2, %0, %3, %3 op_sel:[0,1,0] op_sel_hi:[0,0,0]" : "+v"(c) : "v"(a), "v"(b), "v"(sc)); }
template <class Epi, class Sched>
__device__ __forceinline__ void gemm_phase(LAS unsigned char* lds, const int K, const int lda, const int ldb, const Sched& S, const Epi& E) {
    const int tid = ltid(), wid = __builtin_amdgcn_readfirstlane(tid >> 6), lane = tid & 63, wr = wid >> 2, wc = wid & 3, fr = lane & 15, fq = lane >> 4;
    constexpr bool F8 = Epi::F8;
    constexpr int EB = F8 ? 1 : 2;
    int f8one = 0x7f7f7f79; asm volatile("" : "+v"(f8one)); (void)f8one;
    const int nt = K / (F8 ? 2 * BK : BK);
    unsigned voffA[2], voffB[2];
#pragma unroll
    for (int i = 0; i < 2; ++i) { int R, C; stage_rc(tid * 16 + i * 8192, R, C); const int Rb = Epi::PERM ? ((R & ~31) + perm32(R & 31)) : R;
        voffA[i] = Sched::GATHER ? (unsigned)C * 2u : (unsigned)(R * lda * EB + C * 2); voffB[i] = (unsigned)(Rb * ldb * EB + C * 2); }
    const size_t kstep = (size_t)(BK * 2);
    const size_t hstepA = Sched::GATHER ? 0 : (size_t)HALF * lda * EB, hstepB = (size_t)HALF * ldb * EB;
    const unsigned ldsw = (unsigned)wid * 1024u;
    const int aoff = lds_byte(wr * 64 + fr, F8 ? fq * 16 : fq * 8), boff = lds_byte(wc * 32 + fr, F8 ? fq * 16 : fq * 8);
    const int p16 = F8 ? (fq & 1) * 16 : 0;
    const int aoffK[2] = {aoff + p16, aoff + (F8 ? 16 - p16 : 1024)}, boffK[2] = {boff + p16, boff + (F8 ? 16 - p16 : 1024)};
    unsigned tkC[2] = {0u, 0u}, tkN[2] = {0u, 0u};
#define PG8_SA(b, h) (((b) * 2 + (h)) * HTB)
#define PG8_SB(b, h) ((4 + (b) * 2 + (h)) * HTB)
#define PG8_STAGE(bufoff, gbase, voff) do { _Pragma("unroll") for (int _i = 0; _i < 2; ++_i) \
        __builtin_amdgcn_global_load_lds((const unsigned*)((const char*)(gbase) + (voff)[_i]), (LAS unsigned*)(lds + (bufoff) + ldsw + _i * 8192), 16, 0, 0); } while (0)
#define PG8_STAGE_A(bufoff, p, h, nx) do { if constexpr (Sched::GATHER) { const unsigned _t = (nx) ? tkN[h] : tkC[h]; unsigned _v[2]; _v[0] = ((_t & 0xffffu) << (F8 ? 10 : 11)) + voffA[0]; _v[1] = ((_t >> 16) << (F8 ? 10 : 11)) + voffA[1]; PG8_STAGE(bufoff, p, _v); } \
        else { PG8_STAGE(bufoff, (p) + (h) * hstepA, voffA); } } while (0)
#define PG8_LDA(dst, b, h) do { _Pragma("unroll") for (int m = 0; m < 4; ++m) _Pragma("unroll") for (int k = 0; k < 2; ++k) dst[m][k] = *(const LAS bf16x8*)(lds + PG8_SA(b, h) + aoffK[k] + m * 2048); } while (0)
#define PG8_LDB(dst, b, h) do { _Pragma("unroll") for (int n = 0; n < 2; ++n) _Pragma("unroll") for (int k = 0; k < 2; ++k) dst[n][k] = *(const LAS bf16x8*)(lds + PG8_SB(b, h) + boffK[k] + n * 2048); } while (0)
#define PG8_MMA(ai, bj, At, Bt) do { __builtin_amdgcn_s_setprio(1); \
        if constexpr (F8) { _Pragma("unroll") for (int m = 0; m < 4; ++m) _Pragma("unroll") for (int n = 0; n < 2; ++n) \
            mfma_f8(acc[ai][bj][m][n], cat32(Bt[n][0], Bt[n][1]), cat32(At[m][0], At[m][1]), f8one); } \
        else { _Pragma("unroll") for (int m = 0; m < 4; ++m) _Pragma("unroll") for (int n = 0; n < 2; ++n) _Pragma("unroll") for (int k = 0; k < 2; ++k) \
            acc[ai][bj][m][n] = __builtin_amdgcn_mfma_f32_16x16x32_bf16(Bt[n][k], At[m][k], acc[ai][bj][m][n], 0, 0, 0); } __builtin_amdgcn_s_setprio(0); } while (0)
#define PG8_WAIT_V(n) asm volatile("s_waitcnt vmcnt(" #n ")" ::: "memory")
#define PG8_WAIT_L(n) asm volatile("s_waitcnt lgkmcnt(" #n ")" ::: "memory")
#define PG8_BAR __builtin_amdgcn_s_barrier()
#define PG8_SCHED __builtin_amdgcn_sched_barrier(0)
#define PG8_GV(dst, u) do { if constexpr (Sched::GATHER) { const int _t2 = ltid(); int _R0, _R1, _C; stage_rc(_t2 * 16, _R0, _C); stage_rc(_t2 * 16 + 8192, _R1, _C); \
        _Pragma("unroll") for (int _h = 0; _h < 2; ++_h) dst[_h] = S.row_tok(u, _h * HALF + _R0) | (S.row_tok(u, _h * HALF + _R1) << 16); } } while (0)
    Unit cur, nxt; int ui = 0;
    if (!S.next(0, cur)) return;
    f32x4 acc[2][2][4][2];
#pragma unroll
    for (int a = 0; a < 2; ++a)
#pragma unroll
        for (int b = 0; b < 2; ++b)
#pragma unroll
            for (int m = 0; m < 4; ++m)
#pragma unroll
                for (int n = 0; n < 2; ++n) acc[a][b][m][n] = (f32x4){0.f, 0.f, 0.f, 0.f};
    bf16x8 At[4][2], B0[2][2], B1[2][2];
    const char* cA = S.a_ptr(cur); const char* cB = S.b_ptr(cur);
    PG8_GV(tkC, cur);
    tkN[0] = tkC[0]; tkN[1] = tkC[1];
    PG8_STAGE(PG8_SB(0, 0), cB, voffB); PG8_STAGE(PG8_SB(0, 1), cB + hstepB, voffB); PG8_STAGE_A(PG8_SA(0, 0), cA, 0, false); PG8_STAGE_A(PG8_SA(0, 1), cA, 1, false);
    if (wr == 1) PG8_BAR;
    PG8_WAIT_V(2); PG8_BAR;
    PG8_STAGE(PG8_SB(1, 0), cB + kstep, voffB); PG8_STAGE_A(PG8_SA(1, 0), cA + kstep, 0, false); PG8_STAGE(PG8_SB(1, 1), cB + hstepB + kstep, voffB);
    PG8_WAIT_V(6); PG8_BAR;
    for (;;) {
        const bool has_next = S.next(ui + 1, nxt);
        const char* nA = has_next ? S.a_ptr(nxt) : cA; const char* nB = has_next ? S.b_ptr(nxt) : cB;
        for (int t = 0; t < nt; t += 2) {
            const bool last = (t == nt - 2);
            if constexpr (Sched::GATHER) { if (t == nt - 4 && has_next) PG8_GV(tkN, nxt); }
            const char* a1 = cA + (size_t)(t + 1) * kstep;
            const char* a2 = last ? nA : cA + (size_t)(t + 2) * kstep; const char* b2 = last ? nB : cB + (size_t)(t + 2) * kstep;
            const char* a3 = a2 + kstep; const char* b3 = b2 + kstep;
            const bool nx = last && has_next;
            PG8_LDB(B0, 0, 0); PG8_LDB(B1, 0, 1); PG8_SCHED; PG8_LDA(At, 0, 0); PG8_STAGE_A(PG8_SA(1, 1), a1, 1, false);
            PG8_WAIT_V(8); PG8_WAIT_L(0); PG8_BAR; PG8_MMA(0, 0, At, B0); PG8_MMA(0, 1, At, B1); PG8_BAR; PG8_SCHED;
            PG8_LDA(At, 0, 1); PG8_STAGE(PG8_SB(0, 0), b2, voffB); PG8_STAGE(PG8_SB(0, 1), b2 + hstepB, voffB); PG8_STAGE_A(PG8_SA(0, 0), a2, 0, nx);
            PG8_WAIT_V(8); PG8_WAIT_L(0); PG8_BAR; PG8_MMA(1, 0, At, B0); PG8_MMA(1, 1, At, B1); PG8_BAR; PG8_SCHED;
            PG8_LDB(B0, 1, 0); PG8_LDB(B1, 1, 1); PG8_SCHED; PG8_LDA(At, 1, 0); PG8_STAGE_A(PG8_SA(0, 1), a2, 1, nx);
            PG8_WAIT_V(8); PG8_WAIT_L(0); PG8_BAR; PG8_MMA(0, 0, At, B0); PG8_MMA(0, 1, At, B1); PG8_BAR; PG8_SCHED;
            PG8_LDA(At, 1, 1); PG8_STAGE(PG8_SB(1, 0), b3, voffB); PG8_STAGE(PG8_SB(1, 1), b3 + hstepB, voffB); PG8_STAGE_A(PG8_SA(1, 0), a3, 0, nx);
            PG8_WAIT_V(8); PG8_WAIT_L(0); PG8_BAR; PG8_MMA(1, 0, At, B0); PG8_MMA(1, 1, At, B1); PG8_BAR; PG8_SCHED;
        }
        if (wr == 0) PG8_BAR;
        if constexpr (F8) asm volatile("s_nop 15\n\ts_nop 7" ::: "memory");
        if constexpr (epi_inplace<Epi>::v) E.inplace(acc, cur, wr, wc, fr, fq);
        else if constexpr (!Epi::AFTER_DRAIN) E(acc, cur, wr, wc, fr, fq);
        if (!has_next) break;
        bool clr = true; if constexpr (epi_inplace<Epi>::v) clr = E.clear_after(cur);
        if (clr) {
#pragma unroll
        for (int a = 0; a < 2; ++a)
#pragma unroll
            for (int b = 0; b < 2; ++b)
#pragma unroll
                for (int m = 0; m < 4; ++m)
#pragma unroll
                    for (int n = 0; n < 2; ++n) acc[a][b][m][n] = (f32x4){0.f, 0.f, 0.f, 0.f};
        }
        cur = nxt; cA = nA; cB = nB; ++ui;
        tkC[0] = tkN[0]; tkC[1] = tkN[1];
        if (wr == 1) PG8_BAR;
    }
    PG8_WAIT_V(0);
    PG8_BAR;
    if constexpr (Epi::AFTER_DRAIN) E.fused(acc, cur, wr, wc, fr, fq, lds);
#undef PG8_SA
#undef PG8_SB
#undef PG8_STAGE
#undef PG8_STAGE_A
#undef PG8_LDA
#undef PG8_LDB
#undef PG8_MMA
#undef PG8_WAIT_V
#undef PG8_WAIT_L
#undef PG8_BAR
#undef PG8_SCHED
#undef PG8_GV
}
}
struct Args { const float* in[27]; float* out; unsigned char* ws; int ph_lo, ph_hi, dbg, pad; };
#define CAS __attribute__((address_space(4)))
typedef const CAS Args* ArgsP;
enum { I_X = 0, I_C, I_ADAW, I_ADAB, I_MPREG, I_MPOSTG, I_FPREG, I_FPOSTG, I_WIN, I_GA2, I_GAB, I_CDW, I_CDWB, I_CLNG, I_CLNB, I_GNG, I_WCO, I_WSO, I_WGO, I_WO,
       I_FWG, I_FWU, I_FWD, I_RW, I_MWG, I_MWU, I_MWD };

struct TrItem { const float* src; size_t stride; bf16_t* dst; int dstK; float scale; int f8; };
constexpr int TRK = 256;
constexpr int IT_WIN = 4 * 124 * 4, IT_WCAT = 4 * 16 * 6, IT_WO = 4 * 16 * 4, IT_WGU = 2 * 88 * 4, IT_WDN = 2 * 16 * 11, IT_WMGU = 16 * 112 * 4, IT_WMDN = 16 * 16 * 14, IT_MOD = 4 * 12 * 8;
constexpr int IT_TR = IT_WIN + IT_WCAT + IT_WO + IT_WGU + IT_WDN + IT_WMGU + IT_WMDN, IT_TOTAL = IT_TR + IT_MOD;
__device__ __forceinline__ TrItem tr_item(ArgsP a, int it, int nl) {
    unsigned char* ws = a->ws; TrItem r; r.scale = 1.f; r.f8 = 0;
    if (it < IT_WIN) { const int l = it / 496, q = it % 496, nt = q % 124, kt = q / 124; const int n = nt * 64 + nl;
        int col; if (n < 1024) col = ((nt & 2) ? 512 : 0) + (nt >> 2) * 128 + (nt & 1) * 64 + nl;        else if (n < 4608) col = n; else if (n < 7680) col = n + 16; else if (n < 7696) col = 4608 + (n - 7680); else col = -1;
        r.src = col >= 0 ? a->in[I_WIN] + (size_t)l * 1024 * IN_SRC + (size_t)(kt * TRK) * IN_SRC + col : nullptr; r.stride = IN_SRC;
        r.dst = (bf16_t*)(ws + WS_WIN) + ((size_t)l * NIN + nt * 64) * 1024 + kt * TRK; r.dstK = 1024;
        r.scale = (nt >> 3) == 2 ? 0.125f * LOG2E : (nt >> 3) == 5 ? 0.08838834764831845f : 1.f;
        if (l >= 2) { r.dst = (bf16_t*)(ws + WS_WIN + (size_t)l * NIN * 1024 * 2 + ((size_t)nt * 64) * 1024 + kt * TRK); r.f8 = 1; r.scale *= 64.f; }
        else if (nt >= 72 && nt < 120) { r.dst = (bf16_t*)(ws + WS_WIN + (size_t)l * NIN * 1024 * 2 + (size_t)4608 * 2048 + ((size_t)(nt * 64 - 4608)) * 1024 + kt * TRK); r.f8 = 1; r.scale *= 64.f; }
        return r; }
    it -= IT_WIN;
    if (it < IT_WCAT) { const int l = it / 96, q = it % 96, nt = q % 16, kt = q / 16, which = kt >> 1, ks = (kt & 1) * TRK; const int n = nt * 64 + nl;
        const float* W = which == 0 ? a->in[I_WCO] : which == 1 ? a->in[I_WSO] : a->in[I_WGO];
        r.src = W + (size_t)l * 512 * 1024 + (size_t)ks * 1024 + n; r.stride = 1024; r.dst = (bf16_t*)(ws + WS_WCAT) + ((size_t)l * 1024 + nt * 64) * 1536 + kt * TRK; r.dstK = 1536; return r; }
    it -= IT_WCAT;
    if (it < IT_WO) { const int l = it / 64, q = it % 64, nt = q % 16, kt = q / 16; const int n = nt * 64 + nl;
        r.src = a->in[I_WO] + (size_t)l * 1024 * 1024 + (size_t)(kt * TRK) * 1024 + n; r.stride = 1024; r.dst = (bf16_t*)(ws + WS_WO) + ((size_t)l * 1024 + nt * 64) * 1024 + kt * TRK; r.dstK = 1024; return r; }
    it -= IT_WO;
    if (it < IT_WGU) { const int j = it / 352, q = it % 352, nt = q % 88, kt = q / 88; const int n = nt * 64 + nl;
        const float* W = (nt & 2) ? a->in[I_FWU] : a->in[I_FWG];
        r.src = W + (size_t)j * 1024 * DFF + (size_t)(kt * TRK) * DFF + ((nt >> 2) * 128 + (nt & 1) * 64 + nl); (void)n; r.stride = DFF; r.dst = (bf16_t*)(ws + WS_WGU) + ((size_t)j * 5632 + nt * 64) * 1024 + kt * TRK; r.dstK = 1024;
        { r.dst = (bf16_t*)(ws + WS_WGU + (size_t)j * 5632 * 1024 * 2 + ((size_t)nt * 64) * 1024 + kt * TRK); r.f8 = 1; r.scale = 64.f; }
        return r; }
    it -= IT_WGU;
    if (it < IT_WDN) { const int j = it / 176, q = it % 176, nt = q % 16, kt = q / 16; const int n = nt * 64 + nl;
        r.src = a->in[I_FWD] + (size_t)j * DFF * 1024 + (size_t)(kt * TRK) * 1024 + n; r.stride = 1024; r.dst = (bf16_t*)(ws + WS_WDN) + ((size_t)j * 1024 + nt * 64) * DFF + kt * TRK; r.dstK = DFF;
        { r.dst = (bf16_t*)(ws + WS_WDN + (size_t)j * 1024 * DFF * 2 + ((size_t)nt * 64) * DFF + kt * TRK); r.f8 = 1; r.scale = 64.f; }
        return r; }
    it -= IT_WDN;
    if (it < IT_WMGU) { const int je = it / 448, q = it % 448, nt = q % 112, kt = q / 112; const int n = nt * 64 + nl;
        const float* W = (nt & 2) ? a->in[I_MWU] : a->in[I_MWG];
        r.src = W + (size_t)je * 1024 * DFFE + (size_t)(kt * TRK) * DFFE + ((nt >> 2) * 128 + (nt & 1) * 64 + nl); (void)n; r.stride = DFFE;
        r.dst = (bf16_t*)(ws + WS_WMGU + ((size_t)je * 7168 + nt * 64) * 1024 + kt * TRK); r.dstK = 1024; r.f8 = 1; r.scale = 64.f; return r; }
    it -= IT_WMGU;
    { const int je = it / 224, q = it % 224, nt = q % 16, kt = q / 16; const int n = nt * 64 + nl;
        r.src = a->in[I_MWD] + (size_t)je * DFFE * 1024 + (size_t)(kt * TRK) * 1024 + n; r.stride = 1024; r.dst = (bf16_t*)(ws + WS_WMDN + ((size_t)je * 1024 + nt * 64) * DFFE + kt * TRK); r.dstK = DFFE; r.f8 = 1; r.scale = 64.f; return r; }
}
#define P0_BARRIER() do { asm volatile("s_waitcnt lgkmcnt(0)" ::: "memory"); __builtin_amdgcn_s_barrier(); asm volatile("" ::: "memory"); } while (0)
__device__ __forceinline__ void p0_prologue(LAS unsigned char* lds, ArgsP a) {
    LAS float* T = (LAS float*)lds;
    unsigned char* ws = a->ws; const int tid = ltid(), nl = tid & 63, kq = tid >> 6;
    const int G = lgrid();
    int it = lbid(); float v[32];
    TrItem cur{};
    if (it < IT_TR) { cur = tr_item(a, it, nl); const float* sp = cur.src ? cur.src : a->in[I_ADAB]; const size_t st = cur.src ? cur.stride : 0;
#pragma unroll
        for (int kk = 0; kk < 32; ++kk) v[kk] = sp[(size_t)(kq + 8 * kk) * st]; }
    bool zero = (cur.src == nullptr);
    while (it < IT_TR) {
#pragma unroll
        for (int kk = 0; kk < 32; ++kk) T[nl * 257 + kq + 8 * kk] = zero ? 0.f : v[kk] * cur.scale;
        const int nit = it + G; bf16_t* dst = cur.dst; const int dstK = cur.dstK, f8 = cur.f8;
        if (nit < IT_TR) { cur = tr_item(a, nit, nl); const float* sp = cur.src ? cur.src : a->in[I_ADAB]; const size_t st = cur.src ? cur.stride : 0; zero = (cur.src == nullptr);
#pragma unroll
            for (int kk = 0; kk < 32; ++kk) v[kk] = sp[(size_t)(kq + 8 * kk) * st]; }
        P0_BARRIER();
        if (f8) { const int n2 = tid >> 3, ch = tid & 7; unsigned char* d8 = (unsigned char*)dst;
#pragma unroll
          for (int q2 = 0; q2 < 2; ++q2) { const LAS float* s = T + n2 * 257 + 16 * (ch + 8 * q2); u32x4 o;
              o.x = pk8x4(s[0], s[1], s[2], s[3]);
              o.y = pk8x4(s[4], s[5], s[6], s[7]);
              o.z = pk8x4(s[8], s[9], s[10], s[11]);
              o.w = pk8x4(s[12], s[13], s[14], s[15]);
              *(u32x4*)(d8 + (size_t)n2 * dstK + 16 * (ch + 8 * q2)) = o; } }
        else { const int n2 = tid >> 3, ch = tid & 7;
#pragma unroll
          for (int q4 = 0; q4 < 4; ++q4) { const LAS float* s = T + n2 * 257 + 8 * (ch + 8 * q4);
              u32x4 o; o.x = pk2(s[0], s[1]); o.y = pk2(s[2], s[3]); o.z = pk2(s[4], s[5]); o.w = pk2(s[6], s[7]);
              *(u32x4*)(dst + (size_t)n2 * dstK + 8 * (ch + 8 * q4)) = o; } }
        P0_BARRIER();
        it = nit;
    }
    __syncthreads();
    for (it -= IT_TR; it < IT_MOD; it += G) {
        const int l = it / 96, r = it % 96, cg = r % 12, ks = r / 12; const int n = cg * 512 + tid;
        LAS float* CD = T;
        { const int b = tid >> 7, k = tid & 127; CD[tid] = silu(a->in[I_C][b * 1024 + ks * 128 + k]); }
        __syncthreads();
        const float* W = a->in[I_ADAW] + (size_t)l * 1024 * 6144 + (size_t)(ks * 128) * 6144 + n;
        float s0 = 0.f, s1 = 0.f, s2 = 0.f, s3 = 0.f;
#pragma unroll 8
        for (int k = 0; k < 128; ++k) { const float w = W[(size_t)k * 6144]; s0 += CD[k] * w; s1 += CD[128 + k] * w; s2 += CD[256 + k] * w; s3 += CD[384 + k] * w; }
        float* P = (float*)(ws + WS_MODP) + (size_t)ks * 98304 + (size_t)l * 4 * 6144 + n;
        P[0] = s0; P[6144] = s1; P[2 * 6144] = s2; P[3 * 6144] = s3;
        __syncthreads();
    }
}

struct ThinP {
    const float* xsrc; float* xdst;
    const bf16_t* xsrcb; bf16_t* xdstb;
    int post;
    const bf16_t* y; const bf16_t* oe; const float* gpost; int lpost, gate_off;
    int pre; const float* gpre; int lpre, sh_off, sc_off; bf16_t* H; unsigned char* H8;
    int route; const float* rw; unsigned* cnt;
    int from_partials;
};
__device__ __forceinline__ float mod_val(ArgsP a, int from_partials, int l, int b, int j) {
    const size_t idx = (size_t)(l * 4 + b) * 6144 + j;
    if (from_partials) { const float* P = (const float*)(a->ws + WS_MODP) + idx; float s = a->in[I_ADAB][l * 6144 + j];
#pragma unroll
        for (int ks = 0; ks < 8; ++ks) s += P[(size_t)ks * 98304];
        return s; }
    return ((const float*)(a->ws + WS_MODF))[idx];
}
__device__ __forceinline__ void moe_table(LAS int* tab, const unsigned* wcnt) {
    const int tid = ltid(); LAS int* B = (LAS int*)((LAS unsigned char*)tab + (BASE_OFF - TAB_OFF)); LAS int* GS = (LAS int*)((LAS unsigned char*)tab + (GSUM_OFF - TAB_OFF));
    __syncthreads();
    if (tid < 64) { const int e = tid & 7, g = tid >> 3; int cv[32];
#pragma unroll
        for (int k = 0; k < 32; ++k) cv[k] = (int)wcnt[(g * 32 + k) * 8 + e];
        int run = 0;
#pragma unroll
        for (int k = 0; k < 32; ++k) { B[e * 257 + g * 32 + k] = run; run += cv[k]; }
        GS[g * 8 + e] = run; }
    __syncthreads();
    if (tid < 64) { const int e = tid & 7, g = tid >> 3; int off = 0;
        for (int g2 = 0; g2 < g; ++g2) off += GS[g2 * 8 + e];
        for (int k = 0; k < 32; ++k) B[e * 257 + g * 32 + k] += off;
        if (g == 7) B[e * 257 + 256] = off + GS[56 + e]; }
    __syncthreads();
    if (tid == 0) { int pre = 0;
        for (int e = 0; e < 8; ++e) { const int c = B[e * 257 + 256]; tab[e] = pre; tab[16 + e] = c; pre += (c + 255) >> 8; }
        tab[8] = pre; }
    __syncthreads();
}
template <bool SRCB>
__device__ __forceinline__ void thin_phase(LAS unsigned char* lds, ArgsP a, const ThinP& P) {
    const int tid = ltid(), lane = tid & 63, wid = __builtin_amdgcn_readfirstlane(tid >> 6);
    LAS float* VG = (LAS float*)lds; LAS float* VA = VG + 1024; LAS float* VB = VG + 2048;
    LAS float* RW = (LAS float*)(lds + 12288);
    LAS int* LC = (LAS int*)(lds + 45056);
    LAS int* REC = (LAS int*)(lds + 45056 + 512);
    LAS int* tab = (LAS int*)(lds + TAB_OFF);
    if (P.from_partials) {
        float* MF = (float*)(a->ws + WS_MODF);
        for (int idx = lbid() * 512 + tid; idx < 98304; idx += lgrid() * 512) { const int l = idx / 24576, r = idx % 24576, b = r / 6144, j = r % 6144; MF[idx] = mod_val(a, 1, l, b, j); }
    }
    if (P.post == 2) moe_table(tab, P.cnt);
    for (int rb = lbid(); rb < MTOK / 64; rb += lgrid()) {
        const int b = rb >> 6;
        __syncthreads();
        for (int c = tid; c < 1024; c += 512) {
            if (P.post) VG[c] = mod_val(a, P.from_partials, P.lpost, b, P.gate_off + c) * P.gpost[c];
            if (P.pre) { VA[c] = P.gpre[c] * (1.f + mod_val(a, P.from_partials, P.lpre, b, P.sc_off + c)); VB[c] = mod_val(a, P.from_partials, P.lpre, b, P.sh_off + c); }
        }
        if (P.route) { for (int i = tid; i < 8192; i += 512) RW[(i & 7) * 1024 + (i >> 3)] = P.rw[i]; if (tid < 64) LC[tid] = 0; }
        __syncthreads();
        f32x4 Gr[4], Ar[4], Br[4];
#pragma unroll
        for (int i = 0; i < 4; ++i) { const int c = 256 * i + 4 * lane; Gr[i] = *(const LAS f32x4*)(VG + c); Ar[i] = *(const LAS f32x4*)(VA + c); Br[i] = *(const LAS f32x4*)(VB + c); }
        constexpr int RB = 4;
        const LAS int* BS = (const LAS int*)((const LAS unsigned char*)tab + (BASE_OFF - TAB_OFF));
        const float* OEX = (const float*)(a->ws + WS_OEX);
#pragma unroll 1
        for (int r0 = 0; r0 < 8; r0 += RB) {
            f32x4 xf[RB][4]; u32x2 xq[RB][4], y1q[RB][4], y2q[RB][4]; float pw1[RB], pw2[RB]; size_t g1[RB], g2[RB];
#pragma unroll
            for (int k = 0; k < RB; ++k) { const size_t row = (size_t)rb * 64 + wid * 8 + r0 + k;
#pragma unroll
                for (int i = 0; i < 4; ++i) { if constexpr (SRCB) xq[k][i] = *(const u32x2*)(P.xsrcb + row * 1024 + 256 * i + 4 * lane); else xf[k][i] = *(const f32x4*)(P.xsrc + row * 1024 + 256 * i + 4 * lane); } }
            if (P.post == 1) {
#pragma unroll
                for (int k = 0; k < RB; ++k) { const size_t row = (size_t)rb * 64 + wid * 8 + r0 + k;
#pragma unroll
                    for (int i = 0; i < 4; ++i) y1q[k][i] = *(const u32x2*)(P.y + row * 1024 + 256 * i + 4 * lane); }
            } else if (P.post == 2) {
                int ee[RB], s1[RB], s2[RB];
#pragma unroll
                for (int k = 0; k < RB; ++k) { const size_t row = (size_t)rb * 64 + wid * 8 + r0 + k;
                    ee[k] = ((const int*)(a->ws + WS_TOKE))[row]; s1[k] = ((const int*)(a->ws + WS_TOKS))[row * 2]; s2[k] = ((const int*)(a->ws + WS_TOKS))[row * 2 + 1];
                    pw1[k] = ((const float*)(a->ws + WS_TOKP))[row * 2]; pw2[k] = ((const float*)(a->ws + WS_TOKP))[row * 2 + 1]; }
#pragma unroll
                for (int k = 0; k < RB; ++k) { const int e1 = ee[k] & 255, e2 = (ee[k] >> 8) & 255;
                    g1[k] = (size_t)tab[e1] * 256 + BS[e1 * 257 + rb] + s1[k]; g2[k] = (size_t)tab[e2] * 256 + BS[e2 * 257 + rb] + s2[k];
#pragma unroll
                    for (int i = 0; i < 4; ++i) { y1q[k][i] = *(const u32x2*)(P.oe + g1[k] * 1024 + 256 * i + 4 * lane); y2q[k][i] = *(const u32x2*)(P.oe + g2[k] * 1024 + 256 * i + 4 * lane); } }
            }
#pragma unroll
            for (int k = 0; k < RB; ++k) {
                const int rl = wid * 8 + r0 + k; const size_t row = (size_t)rb * 64 + rl;
                f32x4 x[4];
#pragma unroll
                for (int i = 0; i < 4; ++i) { if constexpr (SRCB) x[i] = (f32x4){bflo(xq[k][i].x), bfhi(xq[k][i].x), bflo(xq[k][i].y), bfhi(xq[k][i].y)};
                    else { x[i] = xf[k][i]; u32x2 wx; wx.x = pk2(x[i][0], x[i][1]); wx.y = pk2(x[i][2], x[i][3]); *(u32x2*)(P.xdstb + row * 1024 + 256 * i + 4 * lane) = wx; } }
                if (P.post) {
                    f32x4 y[4];
                    if (P.post == 1) {
#pragma unroll
                        for (int i = 0; i < 4; ++i) y[i] = (f32x4){bflo(y1q[k][i].x), bfhi(y1q[k][i].x), bflo(y1q[k][i].y), bfhi(y1q[k][i].y)};
                    } else {
#pragma unroll
                        for (int i = 0; i < 4; ++i) { f32x4 y1, y2;
                            if (g1[k] < 32768) y1 = (f32x4){bflo(y1q[k][i].x), bfhi(y1q[k][i].x), bflo(y1q[k][i].y), bfhi(y1q[k][i].y)};
                            else { const float* q = OEX + (g1[k] - 32768) * 1024 + 256 * i + 4 * lane; y1 = *(const f32x4*)q + *(const f32x4*)(q + 2097152); }
                            if (g2[k] < 32768) y2 = (f32x4){bflo(y2q[k][i].x), bfhi(y2q[k][i].x), bflo(y2q[k][i].y), bfhi(y2q[k][i].y)};
                            else { const float* q = OEX + (g2[k] - 32768) * 1024 + 256 * i + 4 * lane; y2 = *(const f32x4*)q + *(const f32x4*)(q + 2097152); }
                            y[i] = y1 * pw1[k] + y2 * pw2[k]; }
                    }
                    float ss = 0.f;
#pragma unroll
                    for (int i = 0; i < 4; ++i) ss += (y[i][0] * y[i][0] + y[i][1] * y[i][1]) + (y[i][2] * y[i][2] + y[i][3] * y[i][3]);
                    const float rstd = 1.0f / sqrtf(wave_sum(ss) * (1.f / 1024.f) + EPS);
#pragma unroll
                    for (int i = 0; i < 4; ++i) x[i] = x[i] + Gr[i] * (y[i] * rstd);
                    if (P.xdst) {
#pragma unroll
                        for (int i = 0; i < 4; ++i) *(f32x4*)(P.xdst + row * 1024 + 256 * i + 4 * lane) = x[i];
                    } else {
#pragma unroll
                        for (int i = 0; i < 4; ++i) { u32x2 wx; wx.x = pk2(x[i][0], x[i][1]); wx.y = pk2(x[i][2], x[i][3]); *(u32x2*)(P.xdstb + row * 1024 + 256 * i + 4 * lane) = wx; }
                    }
                }
                if (P.pre) {
                    float ss = 0.f;
#pragma unroll
                    for (int i = 0; i < 4; ++i) ss += (x[i][0] * x[i][0] + x[i][1] * x[i][1]) + (x[i][2] * x[i][2] + x[i][3] * x[i][3]);
                    const float rstd = 1.0f / sqrtf(wave_sum(ss) * (1.f / 1024.f) + EPS);
                    f32x4 hv[4];
#pragma unroll
                    for (int i = 0; i < 4; ++i) { hv[i] = (x[i] * rstd) * Ar[i] + Br[i];
                        if (P.H8) *(unsigned*)(P.H8 + row * 1024 + 256 * i + 4 * lane) = pk8x4(hv[i][0], hv[i][1], hv[i][2], hv[i][3]);
                        if (P.H) { u32x2 w; w.x = pk2(hv[i][0], hv[i][1]); w.y = pk2(hv[i][2], hv[i][3]); *(u32x2*)(P.H + row * 1024 + 256 * i + 4 * lane) = w; } }
                    if (P.route) {
                        float lg[8];
#pragma unroll
                        for (int e = 0; e < 8; ++e) lg[e] = 0.f;
#pragma unroll
                        for (int i = 0; i < 4; ++i)
                            { f32x4 wv[8];
#pragma unroll
                              for (int e = 0; e < 8; ++e) wv[e] = *(const LAS f32x4*)(RW + e * 1024 + 256 * i + 4 * lane);
#pragma unroll
                              for (int j = 0; j < 4; ++j) { const float hvv = hv[i][j];
#pragma unroll
                                  for (int e = 0; e < 8; ++e) lg[e] += hvv * wv[e][j]; } }
#pragma unroll
                        for (int e = 0; e < 8; ++e) lg[e] = wave_sum(lg[e]);
                        if (lane == 0) {
                            int e1 = 0; float v1 = lg[0];
#pragma unroll
                            for (int e = 1; e < 8; ++e) if (lg[e] > v1) { v1 = lg[e]; e1 = e; }
                            int e2 = -1; float v2 = -3.0e38f;
#pragma unroll
                            for (int e = 0; e < 8; ++e) if (e != e1 && lg[e] > v2) { v2 = lg[e]; e2 = e; }
                            const float p2 = rcp(1.f + ex2(LOG2E * (v1 - v2))), p1 = 1.f - p2;
                            const int k1 = LC[wid * 8 + e1]; LC[wid * 8 + e1] = k1 + 1; const int k2 = LC[wid * 8 + e2]; LC[wid * 8 + e2] = k2 + 1;
                            LAS int* rc = REC + rl * 8; rc[0] = e1; rc[1] = k1; rc[2] = e2; rc[3] = k2; rc[4] = __builtin_bit_cast(int, p1); rc[5] = __builtin_bit_cast(int, p2);
                        }
                    }
                }
            }
        }
        if (P.route) {
            __syncthreads();
            if (tid < 64) { const int e = tid & 7, w = tid >> 3; int off = 0; for (int w2 = 0; w2 < w; ++w2) off += LC[w2 * 8 + e]; LC[64 + w * 8 + e] = off;
                if (w == 7) P.cnt[rb * 8 + e] = (unsigned)(off + LC[56 + e]); }
            __syncthreads();
            if (tid < 64) { const LAS int* rc = REC + tid * 8; const size_t row = (size_t)rb * 64 + tid; const int w = tid >> 3; const int e1 = rc[0], e2 = rc[2]; const int s1 = LC[64 + w * 8 + e1] + rc[1], s2 = LC[64 + w * 8 + e2] + rc[3];
                ((int*)(a->ws + WS_LIST))[(rb * 8 + e1) * 64 + s1] = (int)row; ((int*)(a->ws + WS_LIST))[(rb * 8 + e2) * 64 + s2] = (int)row;
                ((int*)(a->ws + WS_TOKE))[row] = e1 | (e2 << 8); ((int*)(a->ws + WS_TOKS))[row * 2] = s1; ((int*)(a->ws + WS_TOKS))[row * 2 + 1] = s2;
                ((int*)(a->ws + WS_TOKP))[row * 2] = rc[4]; ((int*)(a->ws + WS_TOKP))[row * 2 + 1] = rc[5]; }
        }
    }
    __syncthreads();
}

__device__ __forceinline__ void conv_unit(LAS unsigned char* lds, ArgsP a, int l, int u) {
    const int tid = ltid(), lane = tid & 63, wid = __builtin_amdgcn_readfirstlane(tid >> 6);
    const int b = u >> 7, t0 = (u & 127) * 32; const size_t rowb = (size_t)b * SEQ;
    const bf16_t* Z = (const bf16_t*)(a->ws + WS_R1);
    LAS bf16_t* IN = (LAS bf16_t*)lds;
    LAS float* RED = (LAS float*)lds;
    LAS float* FIN = (LAS float*)(lds + 4096);
    { u32x4 v[8];
#pragma unroll
      for (int x = 0; x < 8; ++x) { const int idx = tid + 512 * x, r = idx >> 6, ch = idx & 63; const int tok = t0 - 30 + r;
          v[x] = (u32x4){0u, 0u, 0u, 0u}; if (r < 62 && tok >= 0) v[x] = *(const u32x4*)(Z + (rowb + tok) * ZP + ZC_GLU + ch * 8); }
#pragma unroll
      for (int x = 0; x < 8; ++x) { const int idx = tid + 512 * x, r = idx >> 6, ch = idx & 63; if (r < 62) *(LAS u32x4*)(IN + r * 512 + ch * 8) = v[x]; } }
    const int c = tid; float w[31];
#pragma unroll
    for (int j = 0; j < 31; ++j) w[j] = a->in[I_CDW][(size_t)l * 31 * 512 + j * 512 + c];
    const float bias = a->in[I_CDWB][l * 512 + c];
    __syncthreads();
    float xr[62];
#pragma unroll
    for (int r = 0; r < 62; ++r) xr[r] = bf2f(IN[r * 512 + c]);
    f32x2 xe[31], xo[31];
#pragma unroll
    for (int k = 0; k < 31; ++k) { xe[k] = (f32x2){xr[2 * k], xr[2 * k + 1]}; xo[k] = (f32x2){xr[2 * k + 1], xr[(2 * k + 2) < 62 ? 2 * k + 2 : 61]}; }
    float acc[32];
#pragma unroll
    for (int u2 = 0; u2 < 16; ++u2) { f32x2 s2 = {bias, bias};
#pragma unroll
        for (int j = 0; j < 31; ++j) { const int r = 2 * u2 + j; s2 = s2 + ((r & 1) ? xo[r >> 1] : xe[r >> 1]) * w[j]; }
        acc[2 * u2] = s2.x; acc[2 * u2 + 1] = s2.y; }
    LAS float* ACC = (LAS float*)(lds + 63488);
#pragma unroll
    for (int t = 0; t < 32; ++t) ACC[t * 513 + c] = acc[t];
    __syncthreads();
    { const int t = tid & 31, sgm = tid >> 5; const LAS float* p = ACC + t * 513 + sgm * 32; float s1 = 0.f, s2 = 0.f;
#pragma unroll
      for (int k = 0; k < 32; ++k) { const float v = p[k]; s1 += v; s2 += v * v; }
      RED[(sgm * 32 + t) * 2] = s1; RED[(sgm * 32 + t) * 2 + 1] = s2; }
    __syncthreads();
    if (tid < 32) { float s1 = 0.f, s2 = 0.f;
#pragma unroll
        for (int wv = 0; wv < 16; ++wv) { s1 += RED[(wv * 32 + tid) * 2]; s2 += RED[(wv * 32 + tid) * 2 + 1]; }
        const float mu = s1 * (1.f / 512.f), var = fmaxf(s2 * (1.f / 512.f) - mu * mu, 0.f); FIN[tid * 2] = mu; FIN[tid * 2 + 1] = 1.0f / sqrtf(var + EPS); }
    __syncthreads();
    const float g = a->in[I_CLNG][l * 512 + c], be = a->in[I_CLNB][l * 512 + c];
    bf16_t* O = (bf16_t*)(a->ws + WS_RM);
#pragma unroll
    for (int t = 0; t < 32; ++t) { const float yv = (acc[t] - FIN[t * 2]) * FIN[t * 2 + 1] * g + be; O[(rowb + t0 + t) * ABCP + c] = (bf16_t)f2bf(silu(yv)); }
}

constexpr int SB_KP = 144;
__device__ __forceinline__ void sb_unit(LAS unsigned char* lds, ArgsP a, int bh, int qb) {
    const int tid = ltid(), lane = tid & 63, wid = __builtin_amdgcn_readfirstlane(tid >> 6), r32 = lane & 31, hi = lane >> 5;
    const int b = bh >> 3, h = bh & 7; const size_t rowb = (size_t)b * SEQ; const int q0 = qb * 256;
    const bf16_t* Z = (const bf16_t*)(a->ws + WS_R1);
    const bf16_t* Zq = Z + ZC_SQ + h * 64; const bf16_t* Zk = Z + ZC_SK + h * 64; const bf16_t* Zv = Z + ZC_SV + h * 64;
    bf16x8 qr[4];
    { const bf16_t* qp = Zq + (rowb + q0 + wid * 32 + r32) * ZP + hi * 8;
#pragma unroll
      for (int d0 = 0; d0 < 4; ++d0) qr[d0] = *(const bf16x8*)(qp + d0 * 16); }
    f32x16 o0, o1;
#pragma unroll
    for (int r = 0; r < 16; ++r) { o0[r] = 0.f; o1[r] = 0.f; }
    float carry = 1.f;
    const int NT = (q0 + 256) / 64;
    const int lrow = tid >> 3, lch = tid & 7;
    const bf16_t* kg = Zk + (rowb + lrow) * ZP + lch * 8; const bf16_t* vg = Zv + (rowb + lrow) * ZP + lch * 8;
    const int KOFF = 0, VOFF = 2 * 64 * SB_KP, BUFB = 64 * SB_KP;
    const int lst = lrow * SB_KP + lch * 16;
    u32x4 kreg = *(const u32x4*)(kg + (size_t)(NT - 1) * 64 * ZP), vreg = *(const u32x4*)(vg + (size_t)(NT - 1) * 64 * ZP);
    *(LAS u32x4*)(lds + KOFF + lst) = kreg; *(LAS u32x4*)(lds + VOFF + lst) = vreg;
    __syncthreads();
    const int qmin = q0 + wid * 32, qmax = qmin + 31, qme = qmin + r32;
    const int kvrow0 = 32 * ((r32 >> 2) & 1) + (r32 & 3) + 4 * (r32 >> 3);
    const int li = lane & 15, lblk = (lane >> 4) & 1;
    const int vtr0 = (32 * hi + (li >> 2)) * SB_KP + (16 * lblk + 4 * (li & 3)) * 2;
    LAS int* ALV = (LAS int*)(lds + 4 * 64 * SB_KP);
    bool dead = false;
    for (int kt = NT - 1; kt >= 0; --kt) {
        const int buf = (NT - 1 - kt) & 1;
        if (kt > 0) { kreg = *(const u32x4*)(kg + (size_t)(kt - 1) * 64 * ZP); vreg = *(const u32x4*)(vg + (size_t)(kt - 1) * 64 * ZP); }
        if (kt * 64 < qmax && !dead) {
            const LAS unsigned char* Kb = lds + KOFF + buf * BUFB; const LAS unsigned char* Vb = lds + VOFF + buf * BUFB;
            f32x16 p0, p1;
#pragma unroll
            for (int r = 0; r < 16; ++r) { p0[r] = 0.f; p1[r] = 0.f; }
#pragma unroll
            for (int d0 = 0; d0 < 4; ++d0) {
                const bf16x8 a0 = *(const LAS bf16x8*)(Kb + kvrow0 * SB_KP + (d0 * 16 + hi * 8) * 2);
                const bf16x8 a1 = *(const LAS bf16x8*)(Kb + (kvrow0 + 16) * SB_KP + (d0 * 16 + hi * 8) * 2);
                p0 = __builtin_amdgcn_mfma_f32_32x32x16_bf16(a0, qr[d0], p0, 0, 0, 0);
                p1 = __builtin_amdgcn_mfma_f32_32x32x16_bf16(a1, qr[d0], p1, 0, 0, 0);
            }
            const bool diag = (kt * 64 + 63 >= qmin);
            const int kv0 = kt * 64 + 32 * hi;
            f32x2 Ec1 = {1.f, 1.f}, Ec0 = {1.f, 1.f}, Pc1 = {1.f, 1.f}, Pc0 = {1.f, 1.f}, dd1[8], dd0[8];
#define SB_CL(x) __builtin_amdgcn_fmed3f((x), -15.f, 3.0e38f)
#define SB_CHAINS(MASKED) do { \
            _Pragma("unroll") for (int i = 7; i >= 0; --i) { \
                f32x2 e1 = {ex2(-SB_CL(p1[8 + i])), ex2(-SB_CL(p1[i]))}, e0 = {ex2(-SB_CL(p0[8 + i])), ex2(-SB_CL(p0[i]))}; \
                f32x2 d1 = e1 + 1.0f, d0 = e0 + 1.0f; \
                if (MASKED) { const bool mA = kv0 + 24 + i >= qme, mB = kv0 + 16 + i >= qme, mC = kv0 + 8 + i >= qme, mD = kv0 + i >= qme; \
                    e1.x = mA ? 1.f : e1.x; d1.x = mA ? 1.f : d1.x; e1.y = mB ? 1.f : e1.y; d1.y = mB ? 1.f : d1.y; e0.x = mC ? 1.f : e0.x; d0.x = mC ? 1.f : d0.x; e0.y = mD ? 1.f : e0.y; d0.y = mD ? 1.f : d0.y; } \
                dd1[i] = d1; dd0[i] = d0; \
                p1[8 + i] = Ec1.x; p1[i] = Ec1.y; p0[8 + i] = Ec0.x; p0[i] = Ec0.y; \
                Ec1 = Ec1 * e1; Ec0 = Ec0 * e0; } \
            _Pragma("unroll") for (int i = 0; i < 8; ++i) { \
                f32x2 w1 = (f32x2){p1[8 + i], p1[i]} * Pc1, w0 = (f32x2){p0[8 + i], p0[i]} * Pc0; \
                if (MASKED) { w1.x = (kv0 + 24 + i >= qme) ? 0.f : w1.x; w1.y = (kv0 + 16 + i >= qme) ? 0.f : w1.y; w0.x = (kv0 + 8 + i >= qme) ? 0.f : w0.x; w0.y = (kv0 + i >= qme) ? 0.f : w0.y; } \
                Pc1 = Pc1 * dd1[i]; Pc0 = Pc0 * dd0[i]; \
                p1[8 + i] = w1.x; p1[i] = w1.y; p0[8 + i] = w0.x; p0[i] = w0.y; } } while (0)
            if (diag) SB_CHAINS(true); else SB_CHAINS(false);
#undef SB_CHAINS
#undef SB_CL
            const float rA = rcp(Pc1.x), rB = rcp(Pc1.y), rC = rcp(Pc0.x), rD = rcp(Pc0.y);
            const float kA = Ec1.x * rA, kB = Ec1.y * rB, kC = Ec0.x * rC, kD = Ec0.y * rD;
            const float L = (kA * kB) * (kC * kD);
            const float Lo = __shfl_xor(L, 32);
            const float start = hi ? carry : carry * Lo;
            carry = carry * L * Lo;
            dead = !__any(carry >= 1.1754944e-38f);
            const float tA = start, tB = tA * kA, tC = tB * kB, tD = tC * kC;
            const float sA = tA * rA, sB = tB * rB, sC = tC * rC, sD = tD * rD;
            bf16x8 pf[4];
            { u32x4 w;
              w.x = pk2(p0[0] * sD, p0[1] * sD); w.y = pk2(p0[2] * sD, p0[3] * sD); w.z = pk2(p0[4] * sD, p0[5] * sD); w.w = pk2(p0[6] * sD, p0[7] * sD); pf[0] = __builtin_bit_cast(bf16x8, w);
              w.x = pk2(p0[8] * sC, p0[9] * sC); w.y = pk2(p0[10] * sC, p0[11] * sC); w.z = pk2(p0[12] * sC, p0[13] * sC); w.w = pk2(p0[14] * sC, p0[15] * sC); pf[1] = __builtin_bit_cast(bf16x8, w);
              w.x = pk2(p1[0] * sB, p1[1] * sB); w.y = pk2(p1[2] * sB, p1[3] * sB); w.z = pk2(p1[4] * sB, p1[5] * sB); w.w = pk2(p1[6] * sB, p1[7] * sB); pf[2] = __builtin_bit_cast(bf16x8, w);
              w.x = pk2(p1[8] * sA, p1[9] * sA); w.y = pk2(p1[10] * sA, p1[11] * sA); w.z = pk2(p1[12] * sA, p1[13] * sA); w.w = pk2(p1[14] * sA, p1[15] * sA); pf[3] = __builtin_bit_cast(bf16x8, w); }
#pragma unroll
            for (int ks = 0; ks < 4; ++ks) {
                const LAS unsigned char* vp = Vb + vtr0 + (8 * ks) * SB_KP;
                const bf16x8 v0 = cat8(trrd(vp), trrd(vp + 4 * SB_KP));
                const bf16x8 v1 = cat8(trrd(vp + 64), trrd(vp + 4 * SB_KP + 64));
                o0 = __builtin_amdgcn_mfma_f32_32x32x16_bf16(pf[ks], v0, o0, 0, 0, 0);
                o1 = __builtin_amdgcn_mfma_f32_32x32x16_bf16(pf[ks], v1, o1, 0, 0, 0);
            }
        }
        if (lane == 0) ALV[(kt & 1) * 8 + wid] = dead ? 0 : 1;
        if (kt > 0) { *(LAS u32x4*)(lds + KOFF + (buf ^ 1) * BUFB + lst) = kreg; *(LAS u32x4*)(lds + VOFF + (buf ^ 1) * BUFB + lst) = vreg; }
        __syncthreads();
        { const LAS int* av = ALV + (kt & 1) * 8; if (((av[0] | av[1]) | (av[2] | av[3])) == 0 && ((av[4] | av[5]) | (av[6] | av[7])) == 0) break; }
    }
    bf16_t* O = (bf16_t*)(a->ws + WS_RM) + 512 + h * 64;
#pragma unroll
    for (int r = 0; r < 16; ++r) { const size_t row = rowb + q0 + wid * 32 + crow(r, hi); O[row * ABCP + r32] = (bf16_t)f2bf(o0[r]); O[row * ABCP + 32 + r32] = (bf16_t)f2bf(o1[r]); }
}

constexpr int GP = 272;
constexpr int G_GL = 0, G_TOT = 4096, G_T0 = 8192, G_T1 = G_T0 + 64 * GP, G_T2 = G_T1 + 64 * GP;
constexpr size_t GS_QD = 0, GS_OI = (size_t)1024 * 64 * 128 * 2, GS_DS = 2 * GS_OI;
__device__ __forceinline__ unsigned fbits(float x) { return __builtin_bit_cast(unsigned, x); }
__device__ __forceinline__ void lds_barrier() { asm volatile("s_waitcnt lgkmcnt(0)" ::: "memory"); __builtin_amdgcn_s_barrier(); asm volatile("" ::: "memory"); }
__device__ __forceinline__ void st_wt16(void* p, u32x4 v) { asm volatile("global_store_dwordx4 %0, %1, off sc1\n\ts_nop 1" :: "v"(p), "v"(v) : "memory"); }
__device__ __forceinline__ void gla_chunk_unit(LAS unsigned char* lds, ArgsP a, int l, int cu, unsigned* gcnt, int pend) {
    const int tid = ltid(), lane = tid & 63, wid = __builtin_amdgcn_readfirstlane(tid >> 6), r32 = lane & 31, hi = lane >> 5;
    const int bh = cu >> 6, n = cu & 63, b = bh >> 2, h = bh & 3; const size_t row0 = (size_t)b * SEQ + n * 64;
    const bf16_t* Z = (const bf16_t*)(a->ws + WS_R1);
    const int jb = wid & 3, tbp = wid >> 2;
    const int j = 32 * jb + r32, g = 2 * tbp + hi;
    LAS unsigned char* QD = lds + G_T0; LAS unsigned char* KI = lds + G_T1; LAS unsigned char* VT = lds + G_T2; LAS unsigned char* KE = lds + G_T2 + 64 * GP;
    LAS float* TOT = (LAS float*)(lds + G_TOT);
    const int pir = 16 * ((r32 >> 2) & 1) + (r32 & 3) + 4 * (r32 >> 3);
    const bf16x8 glf = *(const bf16x8*)(Z + (row0 + 32 * tbp + pir) * ZP + ZC_GLR + 8 * hi);
    float a2v[8];
#pragma unroll
    for (int e = 0; e < 8; ++e) a2v[e] = a->in[I_GA2][(size_t)l * 16 * 512 + (8 * hi + e) * 512 + h * 128 + j];
    const float abj = a->in[I_GAB][l * 512 + h * 128 + j];
    unsigned short qraw[16], kraw[16];
#pragma unroll
    for (int i = 0; i < 16; ++i) { const size_t rr = (row0 + 16 * g + i) * ZP + h * 128 + j; qraw[i] = Z[rr + ZC_GQ]; kraw[i] = Z[rr + ZC_GK]; }
    u32x4 vraw[2];
#pragma unroll
    for (int x = 0; x < 2; ++x) { const int idx = tid + 512 * x, t = idx >> 4, ch = idx & 15; vraw[x] = *(const u32x4*)(Z + (row0 + t) * ZP + ZC_GV + h * 128 + ch * 8); }
#pragma unroll
    for (int x = 0; x < 2; ++x) { const int idx = tid + 512 * x, t = idx >> 4, ch = idx & 15; *(LAS u32x4*)(VT + t * GP + ch * 16) = vraw[x]; }
    f32x16 uu;
    { u32x4 wh, wl; float lo[8];
#pragma unroll
      for (int e = 0; e < 8; ++e) lo[e] = a2v[e] - bf2f(f2bf(a2v[e]));
      wh.x = pk2(a2v[0], a2v[1]); wh.y = pk2(a2v[2], a2v[3]); wh.z = pk2(a2v[4], a2v[5]); wh.w = pk2(a2v[6], a2v[7]);
      wl.x = pk2(lo[0], lo[1]); wl.y = pk2(lo[2], lo[3]); wl.z = pk2(lo[4], lo[5]); wl.w = pk2(lo[6], lo[7]);
#pragma unroll
      for (int r = 0; r < 16; ++r) uu[r] = abj;
      uu = __builtin_amdgcn_mfma_f32_32x32x16_bf16(glf, __builtin_bit_cast(bf16x8, wh), uu, 0, 0, 0);
      uu = __builtin_amdgcn_mfma_f32_32x32x16_bf16(glf, __builtin_bit_cast(bf16x8, wl), uu, 0, 0, 0); }
    float bc[16]; float run = 0.f;
#pragma unroll
    for (int i = 0; i < 16; ++i) { run += logsig(uu[i]) * 0.0625f; bc[i] = run; }
    TOT[g * 128 + j] = run;
    asm volatile("s_waitcnt vmcnt(0)" ::: "memory");
    __syncthreads();
    if (pend >= 0 && tid == 0) __hip_atomic_fetch_add(gcnt + pend * 64, 1u, __ATOMIC_RELAXED, __HIP_MEMORY_SCOPE_AGENT);
    float off = 0.f, blast = 0.f;
#pragma unroll
    for (int g2 = 0; g2 < 4; ++g2) { const float v = TOT[g2 * 128 + j]; blast += v; if (g2 < g) off += v; }
    const float dec = ex2(LOG2E * blast);
#pragma unroll
    for (int i = 0; i < 16; i += 2) { const int t = 16 * g + i;
        const float e0 = ex2(LOG2E * (bc[i] + off)), e1 = ex2(LOG2E * (bc[i + 1] + off)), k0 = bf2f(kraw[i]) * rcp(e0), k1 = bf2f(kraw[i + 1]) * rcp(e1);
        const unsigned wq = pk2(bf2f(qraw[i]) * e0, bf2f(qraw[i + 1]) * e1), wk = pk2(k0, k1), we = pk2(k0 * dec, k1 * dec);
        *(LAS bf16_t*)(QD + t * GP + j * 2) = (bf16_t)wq; *(LAS bf16_t*)(QD + (t + 1) * GP + j * 2) = (bf16_t)(wq >> 16);
        *(LAS bf16_t*)(KI + t * GP + j * 2) = (bf16_t)wk; *(LAS bf16_t*)(KI + (t + 1) * GP + j * 2) = (bf16_t)(wk >> 16);
        *(LAS bf16_t*)(KE + t * GP + j * 2) = (bf16_t)we; *(LAS bf16_t*)(KE + (t + 1) * GP + j * 2) = (bf16_t)(we >> 16); }
    if (g == 0) __hip_atomic_store((float*)(a->ws + WS_DECAY) + (size_t)cu * 128 + j, dec, __ATOMIC_RELAXED, __HIP_MEMORY_SCOPE_AGENT);
    lds_barrier();
    { bf16_t* QDg = (bf16_t*)(a->ws + WS_RY + GS_QD) + (size_t)cu * 8192;
#pragma unroll
      for (int x = 0; x < 2; ++x) { const int idx = tid + 512 * x, t = idx >> 4, ch = idx & 15; st_wt16(QDg + t * 128 + ch * 8, *(const LAS u32x4*)(QD + t * GP + ch * 16)); } }
    { const int jvb = wid >> 1, jkb0 = 2 * (wid & 1); const int li2 = lane & 15, lblk2 = (lane >> 4) & 1;
      const int trb = (8 * hi + (li2 >> 2)) * GP + (16 * lblk2 + 4 * (li2 & 3)) * 2;
      f32x16 c0, c1;
#pragma unroll
      for (int r = 0; r < 16; ++r) { c0[r] = 0.f; c1[r] = 0.f; }
#pragma unroll
      for (int kt = 0; kt < 4; ++kt) {
          const LAS unsigned char* vp = VT + trb + (16 * kt) * GP + (32 * jvb) * 2; const LAS unsigned char* kp = KE + trb + (16 * kt) * GP + (32 * jkb0) * 2;
          const bf16x8 af = cat8(trrd(vp), trrd(vp + 4 * GP));
          const bf16x8 b0 = cat8(trrd(kp), trrd(kp + 4 * GP)), b1 = cat8(trrd(kp + 64), trrd(kp + 4 * GP + 64));
          c0 = __builtin_amdgcn_mfma_f32_32x32x16_bf16(af, b0, c0, 0, 0, 0); c1 = __builtin_amdgcn_mfma_f32_32x32x16_bf16(af, b1, c1, 0, 0, 0);
      }
      bf16_t* DS = (bf16_t*)(a->ws + WS_RY + GS_DS) + (size_t)cu * 16384 + tid * 8;
#pragma unroll
      for (int q4 = 0; q4 < 2; ++q4) { st_wt16(DS + 4096 * q4, (u32x4){pk2(c0[8 * q4], c0[8 * q4 + 1]), pk2(c0[8 * q4 + 2], c0[8 * q4 + 3]), pk2(c0[8 * q4 + 4], c0[8 * q4 + 5]), pk2(c0[8 * q4 + 6], c0[8 * q4 + 7])});
          st_wt16(DS + 8192 + 4096 * q4, (u32x4){pk2(c1[8 * q4], c1[8 * q4 + 1]), pk2(c1[8 * q4 + 2], c1[8 * q4 + 3]), pk2(c1[8 * q4 + 4], c1[8 * q4 + 5]), pk2(c1[8 * q4 + 6], c1[8 * q4 + 7])}); } }
    const int tb = wid & 1, jq = wid >> 1; const int li = lane & 15, lblk = (lane >> 4) & 1;
    bf16x8 pf[2][2];
#pragma unroll
    for (int sb = 0; sb < 2; ++sb) {
        if (sb <= tb) {
            f32x16 d;
#pragma unroll
            for (int r = 0; r < 16; ++r) d[r] = 0.f;
#pragma unroll
            for (int kk = 0; kk < 8; ++kk) { const bf16x8 af = *(const LAS bf16x8*)(KI + (32 * sb + r32) * GP + (16 * kk + 8 * hi) * 2), bf = *(const LAS bf16x8*)(QD + (32 * tb + r32) * GP + (16 * kk + 8 * hi) * 2);
                d = __builtin_amdgcn_mfma_f32_32x32x16_bf16(af, bf, d, 0, 0, 0); }
            if (sb == tb) {
#pragma unroll
                for (int r = 0; r < 16; ++r) if (crow(r, hi) > r32) d[r] = 0.f;
            }
#pragma unroll
            for (int st = 0; st < 2; ++st) { u32x4 w; w.x = pk2(d[8 * st + 0], d[8 * st + 1]); w.y = pk2(d[8 * st + 2], d[8 * st + 3]); w.z = pk2(d[8 * st + 4], d[8 * st + 5]); w.w = pk2(d[8 * st + 6], d[8 * st + 7]); pf[sb][st] = __builtin_bit_cast(bf16x8, w); }
        } else { pf[sb][0] = (bf16x8){0, 0, 0, 0, 0, 0, 0, 0}; pf[sb][1] = (bf16x8){0, 0, 0, 0, 0, 0, 0, 0}; }
    }
    f32x16 o;
#pragma unroll
    for (int r = 0; r < 16; ++r) o[r] = 0.f;
#pragma unroll
    for (int sb = 0; sb < 2; ++sb)
#pragma unroll
        for (int st = 0; st < 2; ++st) {
            const LAS unsigned char* vp = VT + (32 * sb + 16 * st + 4 * hi + (li >> 2)) * GP + (32 * jq + 16 * lblk + 4 * (li & 3)) * 2;
            const bf16x8 af = cat8(trrd(vp), trrd(vp + 8 * GP));
            o = __builtin_amdgcn_mfma_f32_32x32x16_bf16(af, pf[sb][st], o, 0, 0, 0);
        }
    { bf16_t* OI = (bf16_t*)(a->ws + WS_RY + GS_OI) + (size_t)cu * 8192 + tid * 8;
#pragma unroll
      for (int q4 = 0; q4 < 2; ++q4) st_wt16(OI + 4096 * q4, (u32x4){pk2(o[8 * q4], o[8 * q4 + 1]), pk2(o[8 * q4 + 2], o[8 * q4 + 3]), pk2(o[8 * q4 + 4], o[8 * q4 + 5]), pk2(o[8 * q4 + 6], o[8 * q4 + 7])}); }
}
constexpr size_t GS_SN = 0;
__device__ __forceinline__ void gla_scan_unit(ArgsP a, int bh, int q, unsigned* sdone) {
    const int tid = ltid(), lane = tid & 63, wid = __builtin_amdgcn_readfirstlane(tid >> 6), r32 = lane & 31;
    const int jkb = 2 * (wid & 1) + (q >> 1);
    const bf16_t* DSg = (const bf16_t*)(a->ws + WS_RY + GS_DS) + (size_t)bh * 64 * 16384 + 4096 * q + tid * 8;
    bf16_t* SNg = (bf16_t*)(a->ws + WS_MRG + GS_SN) + (size_t)bh * 64 * 16384 + 4096 * q + tid * 8;
    const float* DECg = (const float*)(a->ws + WS_DECAY) + (size_t)bh * 64 * 128 + 32 * jkb + r32;
    float st[8];
#pragma unroll
    for (int i = 0; i < 8; ++i) st[i] = 0.f;
    u32x4 dv[16]; float dc[16];
#pragma unroll
    for (int k = 0; k < 16; ++k) { dv[k] = *(const u32x4*)(DSg + (size_t)k * 16384); dc[k] = DECg[k * 128]; }
#pragma unroll 1
    for (int nb = 0; nb < 64; nb += 16) {
        u32x4 dn[16]; float cn[16];
        const int nn = nb + 16 < 64 ? nb + 16 : nb;
#pragma unroll
        for (int k = 0; k < 16; ++k) { dn[k] = *(const u32x4*)(DSg + (size_t)(nn + k) * 16384); cn[k] = DECg[(nn + k) * 128]; }
#pragma unroll
        for (int k = 0; k < 16; ++k) {
            st_wt16(SNg + (size_t)(nb + k) * 16384, (u32x4){pk2(st[0], st[1]), pk2(st[2], st[3]), pk2(st[4], st[5]), pk2(st[6], st[7])});
            st[0] = st[0] * dc[k] + bflo(dv[k].x); st[1] = st[1] * dc[k] + bfhi(dv[k].x); st[2] = st[2] * dc[k] + bflo(dv[k].y); st[3] = st[3] * dc[k] + bfhi(dv[k].y);
            st[4] = st[4] * dc[k] + bflo(dv[k].z); st[5] = st[5] * dc[k] + bfhi(dv[k].z); st[6] = st[6] * dc[k] + bflo(dv[k].w); st[7] = st[7] * dc[k] + bfhi(dv[k].w); }
#pragma unroll
        for (int k = 0; k < 16; ++k) { dv[k] = dn[k]; dc[k] = cn[k]; }
    }
    asm volatile("s_waitcnt vmcnt(0)" ::: "memory");
    __syncthreads();
    if (tid == 0) __hip_atomic_fetch_add(sdone + bh * 64, 1u, __ATOMIC_RELAXED, __HIP_MEMORY_SCOPE_AGENT);
}
constexpr int R_SS = 0, R_QD = 1024, R_SL = R_QD + 64 * GP, R_SG = R_SL + 128 * GP, R_END = R_SG + 64 * GP;
static_assert(R_END <= RING_BYTES, "GLA LDS map");
__device__ __forceinline__ void gla_out_unit(LAS unsigned char* lds, ArgsP a, int l, int cu) {
    const int tid = ltid(), lane = tid & 63, wid = __builtin_amdgcn_readfirstlane(tid >> 6), r32 = lane & 31, hi = lane >> 5;
    const int bh = cu >> 6, n = cu & 63, b = bh >> 2, h = bh & 3; const size_t row0 = (size_t)b * SEQ + n * 64;
    const bf16_t* Z = (const bf16_t*)(a->ws + WS_R1);
    LAS float* SS = (LAS float*)(lds + R_SS);
    LAS unsigned char* QD = lds + R_QD; LAS unsigned char* SL = lds + R_SL;
    const int tb = wid & 1, jq = wid >> 1, jvb = wid >> 1, jkb0 = 2 * (wid & 1);
    const int sl_li = lane & 15, sl_tr = (8 * hi + (sl_li >> 2)) * GP + (32 * jq + 16 * ((lane >> 4) & 1) + 4 * (sl_li & 3)) * 2;
    const int t0 = tid >> 4, ch0 = tid & 15;
    const bf16_t* QDg = (const bf16_t*)(a->ws + WS_RY + GS_QD) + (size_t)cu * 8192;
    u32x4 qv[2], sn[4], oi[2], sgv[2]; u32x2 sg[4]; f32x4 gn[4];
#pragma unroll
    for (int x = 0; x < 2; ++x) qv[x] = *(const u32x4*)(QDg + (t0 + 32 * x) * 128 + ch0 * 8);
#pragma unroll
    for (int x = 0; x < 4; ++x) sn[x] = *(const u32x4*)((const bf16_t*)(a->ws + WS_MRG + GS_SN) + (size_t)cu * 16384 + 4096 * x + tid * 8);
#pragma unroll
    for (int x = 0; x < 2; ++x) oi[x] = *(const u32x4*)((const bf16_t*)(a->ws + WS_RY + GS_OI) + (size_t)cu * 8192 + 4096 * x + tid * 8);
    const size_t tok = row0 + 32 * tb + r32;
#pragma unroll
    for (int rg = 0; rg < 4; ++rg) gn[rg] = *(const f32x4*)(a->in[I_GNG] + l * 512 + h * 128 + 32 * jq + 8 * rg + 4 * hi);
#pragma unroll
    for (int x = 0; x < 2; ++x) sgv[x] = *(const u32x4*)(Z + (row0 + t0 + 32 * x) * ZP + ZC_GG + h * 128 + ch0 * 8);
#pragma unroll
    for (int x = 0; x < 2; ++x) { *(LAS u32x4*)(QD + (t0 + 32 * x) * GP + ch0 * 16) = qv[x]; *(LAS u32x4*)(lds + R_SG + (t0 + 32 * x) * GP + ch0 * 16) = sgv[x]; }
#pragma unroll
    for (int g4 = 0; g4 < 4; ++g4) { const u32x4 v0 = sn[g4 >> 1], v1 = sn[2 + (g4 >> 1)];
        *(LAS u32x2*)(SL + (32 * jkb0 + r32) * GP + (32 * jvb + 8 * g4 + 4 * hi) * 2) = (g4 & 1) ? (u32x2){v0.z, v0.w} : (u32x2){v0.x, v0.y};
        *(LAS u32x2*)(SL + (32 * jkb0 + 32 + r32) * GP + (32 * jvb + 8 * g4 + 4 * hi) * 2) = (g4 & 1) ? (u32x2){v1.z, v1.w} : (u32x2){v1.x, v1.y}; }
    f32x16 o;
#pragma unroll
    for (int x = 0; x < 2; ++x) { o[8 * x] = bflo(oi[x].x); o[8 * x + 1] = bfhi(oi[x].x); o[8 * x + 2] = bflo(oi[x].y); o[8 * x + 3] = bfhi(oi[x].y);
        o[8 * x + 4] = bflo(oi[x].z); o[8 * x + 5] = bfhi(oi[x].z); o[8 * x + 6] = bflo(oi[x].w); o[8 * x + 7] = bfhi(oi[x].w); }
    __syncthreads();
#pragma unroll
    for (int rg = 0; rg < 4; ++rg) sg[rg] = *(const LAS u32x2*)(lds + R_SG + (32 * tb + r32) * GP + (32 * jq + 8 * rg + 4 * hi) * 2);
#pragma unroll
    for (int kk = 0; kk < 8; ++kk) { const LAS unsigned char* sp = SL + sl_tr + (16 * kk) * GP;
        const bf16x8 af = cat8(trrd(sp), trrd(sp + 4 * GP)), bf = *(const LAS bf16x8*)(QD + (32 * tb + r32) * GP + (16 * kk + 8 * hi) * 2);
        o = __builtin_amdgcn_mfma_f32_32x32x16_bf16(af, bf, o, 0, 0, 0); }
    float ss = 0.f;
#pragma unroll
    for (int r = 0; r < 16; ++r) ss += o[r] * o[r];
    ss += __shfl_xor(ss, 32);
    if (hi == 0) SS[jq * 64 + 32 * tb + r32] = ss;
    __syncthreads();
    { const float tot = (SS[32 * tb + r32] + SS[64 + 32 * tb + r32]) + (SS[128 + 32 * tb + r32] + SS[192 + 32 * tb + r32]);
      const float rstd = 1.0f / sqrtf(tot * (1.f / 128.f) + EPS);
#pragma unroll
      for (int rg = 0; rg < 4; ++rg) { const int col = 32 * jq + 8 * rg + 4 * hi;
          u32x2 w; w.x = pk2(o[4 * rg] * rstd * gn[rg][0] * bflo(sg[rg].x), o[4 * rg + 1] * rstd * gn[rg][1] * bfhi(sg[rg].x)); w.y = pk2(o[4 * rg + 2] * rstd * gn[rg][2] * bflo(sg[rg].y), o[4 * rg + 3] * rstd * gn[rg][3] * bfhi(sg[rg].y));
          *(LAS u32x2*)(QD + (32 * tb + r32) * GP + col * 2) = w; } }
    __syncthreads();
    { bf16_t* O = (bf16_t*)(a->ws + WS_RM) + row0 * ABCP + 1024 + h * 128;
#pragma unroll
      for (int x = 0; x < 2; ++x) *(u32x4*)(O + (size_t)(t0 + 32 * x) * ABCP + ch0 * 8) = *(const LAS u32x4*)(QD + (t0 + 32 * x) * GP + ch0 * 16); }
}
constexpr int NPHASE = 2 + 8 * NLAYER;
constexpr int CW_FLAG = 16384;
constexpr int CW_GCNT = 24576;
constexpr int CW_Q = 12288;
__device__ __forceinline__ ArgsP fresh_args() { const CAS void* p = (const CAS void*)__builtin_amdgcn_kernarg_segment_ptr(); asm volatile("" : "+s"(p)); return (ArgsP)p; }
#define PHASE_ENV ArgsP a = fresh_args(); const int G = lgrid(), c = lbid(); (void)G; (void)c; unsigned char* ws = a->ws; unsigned* ctl = (unsigned*)(ws + WS_CTL); (void)ctl; \
    bf16_t* Z = (bf16_t*)(ws + WS_R1); bf16_t* ACT = (bf16_t*)(ws + WS_R1); bf16_t* H = (bf16_t*)(ws + WS_H); bf16_t* Y = (bf16_t*)(ws + WS_RY); bf16_t* OE = (bf16_t*)(ws + WS_RY); \
    bf16_t* ABC = (bf16_t*)(ws + WS_RM); bf16_t* MRG = (bf16_t*)(ws + WS_MRG); float* XA = (float*)(ws + WS_RM); (void)Z; (void)ACT; (void)H; (void)Y; (void)OE; (void)ABC; (void)MRG; (void)XA;
__global__ void __launch_bounds__(512, 2) fwd_kernel(Args a_in) {
    extern __shared__ __attribute__((aligned(16))) unsigned char shm[];
    LAS unsigned char* lds = (LAS unsigned char*)shm;
    const int tid = threadIdx.x;
    unsigned* ctl0 = (unsigned*)(a_in.ws + WS_CTL);
    if (tid < 4) ((LAS unsigned*)(lds + MISC_OFF))[tid] = 0u;
    __syncthreads();
    XcdBarrier bar; bar.bar = ctl0 + CW_BAR; bar.x = 0; bar.st = nullptr;
    const int lo = a_in.ph_lo, hi = a_in.ph_hi;
    if (hi - lo > 1) bar = xcd_barrier_post(ctl0 + CW_BAR, (volatile LAS unsigned*)(lds + MISC_OFF));
#define IN(k) (lo <= (k) && (k) < hi)
#define SEAM(k) do { if (IN(k) && IN((k) + 1)) { XcdBarrier _b = bar; asm volatile("" : "+s"(_b.bar)); xcd_barrier(_b); } } while (0)
        LAS int* tab = (LAS int*)(lds + TAB_OFF);

    if (IN(0)) { PHASE_ENV p0_prologue(lds, a); }
    SEAM(0);
    if (IN(1)) { PHASE_ENV ThinP P{}; P.xsrc = a->in[I_X]; P.xsrcb = nullptr; P.xdst = nullptr; P.xdstb = (bf16_t*)a->out; P.post = 0; P.pre = 1; P.gpre = a->in[I_MPREG]; P.lpre = 0; P.sh_off = 0; P.sc_off = 1024; P.H = H; P.H8 = (unsigned char*)(a->ws + WS_HG8); P.route = 0; P.from_partials = 1; thin_phase<false>(lds, a, P); }
    SEAM(1);
    for (int l = 0; l < NLAYER; ++l) {
        const int pb = 2 + 8 * l, j = l >> 1;
        if (IN(pb + 0)) { PHASE_ENV
            if (l >= 2) { pg8::InSched S{G, c, (const char*)H, (const char*)(ws + WS_WIN) + (size_t)l * NIN * 1024 * 2, (size_t)256 * 1024, (size_t)256 * 1024, 0, 31 * 64};
                pg8::EpiInF8 E{Z}; pg8::gemm_phase<pg8::EpiInF8, pg8::InSched>(lds, 1024, 1024, 1024, S, E); }
            else {
                { pg8::InSched S{G, c, (const char*)(ws + WS_HG8), (const char*)(ws + WS_WIN) + (size_t)l * NIN * 1024 * 2 + (size_t)4608 * 2048 - (size_t)18 * 256 * 1024, (size_t)256 * 1024, (size_t)256 * 1024, 0, 768};
                  pg8::EpiInF8 E{Z}; pg8::gemm_phase<pg8::EpiInF8, pg8::InSched>(lds, 1024, 1024, 1024, S, E); }
                { pg8::InSched S{G, c, (const char*)H, (const char*)(ws + WS_WIN) + (size_t)l * NIN * 1024 * 2, (size_t)256 * 1024 * 2, (size_t)256 * 1024 * 2, 768, 31 * 64};
                  pg8::EpiIn E{Z}; pg8::gemm_phase<pg8::EpiIn, pg8::InSched>(lds, 1024, 1024, 1024, S, E); } }
        }
        SEAM(pb + 0);
        if (IN(pb + 1)) { PHASE_ENV
            unsigned* gcnt = ctl + CW_GCNT + 1024 * l; unsigned* sdone = ctl + CW_FLAG + 1024 * l; unsigned* tmo = ctl + CW_BAR + XB_TMO;
            unsigned* q0 = ctl + CW_Q + 64 * l; unsigned* q1 = q0 + 32;
            LAS int* slot = (LAS int*)(lds + TAB_OFF + 128);
            int nxt = 0; bool t0q0 = true; int pend = -1;
            int zv = 0; asm volatile("" : "+v"(zv));
            if (ltid() == 0) nxt = (int)__hip_atomic_fetch_add(q0 + zv, 1u, __ATOMIC_RELAXED, __HIP_MEMORY_SCOPE_AGENT);
            for (;;) {
                lds_barrier();
                if (ltid() == 0) { int v = nxt + (t0q0 ? 0 : 2048);
                    if (t0q0 && v >= 1088) { t0q0 = false; v = 2048 + (int)__hip_atomic_fetch_add(q1 + zv, 1u, __ATOMIC_RELAXED, __HIP_MEMORY_SCOPE_AGENT); }
                    *slot = v;
                    nxt = (int)__hip_atomic_fetch_add((t0q0 ? q0 : q1) + zv, 1u, __ATOMIC_RELAXED, __HIP_MEMORY_SCOPE_AGENT); }
                lds_barrier();
                const int u = *slot;
                if (u < 1024) { gla_chunk_unit(lds, a, l, u, gcnt, pend); pend = u >> 6; continue; }
                if (pend >= 0) { asm volatile("s_waitcnt vmcnt(0)" ::: "memory"); lds_barrier(); if (ltid() == 0) __hip_atomic_fetch_add(gcnt + pend * 64, 1u, __ATOMIC_RELAXED, __HIP_MEMORY_SCOPE_AGENT); pend = -1; }
                if (u >= 2048 + 2048) break;
                if (u < 1088 || u >= 2048 + 1024) {
                    if (ltid() == 0) { unsigned* w; unsigned need;
                        if (u < 1088) { w = gcnt + ((u - 1024) >> 2) * 64; need = 64u; } else { w = sdone + ((u - 2048 - 1024) >> 6) * 64; need = 4u; }
                        unsigned sp = 0;
                        while (__hip_atomic_load(w, __ATOMIC_RELAXED, __HIP_MEMORY_SCOPE_AGENT) < need) { __builtin_amdgcn_s_sleep(4);
                            if ((++sp & 255u) == 0u) { if (__hip_atomic_load(tmo, __ATOMIC_RELAXED, __HIP_MEMORY_SCOPE_AGENT) != 0u) break; if (sp > (1u << 22)) { __hip_atomic_store(tmo, 1u, __ATOMIC_RELAXED, __HIP_MEMORY_SCOPE_AGENT); break; } } }
                        __builtin_amdgcn_fence(__ATOMIC_ACQUIRE, "agent"); asm volatile("s_waitcnt vmcnt(0)" ::: "memory"); }
                    lds_barrier(); }
                if (u < 1088) gla_scan_unit(a, (u - 1024) >> 2, (u - 1024) & 3, sdone);
                else if (u < 2048 + 512) sb_unit(lds, a, (u - 2048) & 31, 15 - ((u - 2048) >> 5));
                else if (u < 2048 + 1024) conv_unit(lds, a, l, u - 2048 - 512);
                else gla_out_unit(lds, a, l, u - 2048 - 1024); }
        }
        SEAM(pb + 1);
        if (IN(pb + 2)) { PHASE_ENV
            pg8::CatSched S{G, c, (const char*)ABC, (const char*)(ws + WS_WCAT) + (size_t)l * 1024 * 1536 * 2, (size_t)256 * 1536 * 2, (size_t)256 * 1536 * 2};
            pg8::EpiMergeR E{Z + ZC_GATE, MRG}; pg8::gemm_phase<pg8::EpiMergeR, pg8::CatSched>(lds, 512, 1536, 1536, S, E);
        }
        SEAM(pb + 2);
        if (IN(pb + 3)) { PHASE_ENV
            pg8::DenseSched S{64, 4, G, c, (const char*)MRG, (const char*)(ws + WS_WO) + (size_t)l * 1024 * 1024 * 2, (size_t)256 * 1024 * 2, (size_t)256 * 1024 * 2};
            if (l & 1) { pg8::EpiBf16 E{Y, 1024}; pg8::gemm_phase<pg8::EpiBf16, pg8::DenseSched>(lds, 1024, 1024, 1024, S, E); }
            else {
                pg8::EpiFuse E{(const bf16_t*)a->out, (bf16_t*)XA, H, (const float*)(ws + WS_MODF), a->in[I_MPOSTG] + l * 1024, a->in[I_FPREG] + l * 1024, l, l, 2048, 4096, 3072,
                               (f32x4*)(ws + WS_OEX) + (size_t)(l >> 1) * 65536, ctl + CW_CNT + (l >> 1) * 64, ctl + CW_BAR + XB_TMO, 1, nullptr};
                pg8::gemm_phase<pg8::EpiFuse, pg8::DenseSched>(lds, 1024, 1024, 1024, S, E); }
        }
        if (l & 1) SEAM(pb + 3);
        if ((l & 1) && IN(pb + 4)) { PHASE_ENV ThinP P{}; P.xsrc = nullptr; P.xsrcb = (const bf16_t*)a->out; P.xdst = nullptr; P.xdstb = (bf16_t*)XA; P.post = 1; P.y = Y; P.gpost = a->in[I_MPOSTG] + l * 1024; P.lpost = l; P.gate_off = 2048;
            P.pre = 1; P.gpre = a->in[I_FPREG] + l * 1024; P.lpre = l; P.sh_off = 3072; P.sc_off = 4096; P.H = nullptr; P.H8 = (unsigned char*)H; P.route = l & 1; P.rw = a->in[I_RW] + (size_t)j * 8192; P.cnt = ctl + CW_WCNT + j * 2048; P.from_partials = 0;
            thin_phase<true>(lds, a, P); }
        SEAM(pb + 4);
        if (l & 1) {
            if (IN(pb + 5)) { PHASE_ENV moe_table(tab, ctl + CW_WCNT + j * 2048);
                pg8::MoeSched<true> S{28, G, c, tab, (const char*)H, (const char*)(ws + WS_WMGU) + (size_t)j * 8 * 7168 * 1024, 0, (size_t)256 * 1024, (size_t)7168 * 1024, (const int*)(ws + WS_LIST), 1024u, 1 << 20};
                pg8::EpiSwigluF8 E{ACT, DFFE}; pg8::gemm_phase<pg8::EpiSwigluF8, pg8::MoeSched<true>>(lds, 1024, 1024, 1024, S, E); }
            SEAM(pb + 5);
            if (IN(pb + 6)) { PHASE_ENV moe_table(tab, ctl + CW_WCNT + j * 2048);
                pg8::MoeSched<false> S{4, G, c, tab, (const char*)ACT, (const char*)(ws + WS_WMDN) + (size_t)j * 8 * 1024 * DFFE, (size_t)256 * DFFE, (size_t)256 * DFFE, (size_t)1024 * DFFE, nullptr, 0u, 128};
                pg8::EpiBf16F8 E{OE, 1024}; pg8::gemm_phase<pg8::EpiBf16F8, pg8::MoeSched<false>>(lds, DFFE, DFFE, DFFE, S, E);
                pg8::MoeTailSched S2{G, c, tab, (const char*)ACT, (const char*)(ws + WS_WMDN) + (size_t)j * 8 * 1024 * DFFE, (size_t)256 * DFFE, (size_t)256 * DFFE, (size_t)1024 * DFFE};
                pg8::EpiF32F8 E2{(float*)(ws + WS_OEX), 1024}; pg8::gemm_phase<pg8::EpiF32F8, pg8::MoeTailSched>(lds, pg8::MoeTailSched::KS, DFFE, DFFE, S2, E2); }
        } else {
            if (IN(pb + 5)) { PHASE_ENV
                if (true) { pg8::DenseSched S{64, 22, G, c, (const char*)H, (const char*)(ws + WS_WGU) + (size_t)j * 5632 * 1024 * 2, (size_t)256 * 1024, (size_t)256 * 1024};
                    pg8::EpiSwigluF8 E{ACT, DFF}; pg8::gemm_phase<pg8::EpiSwigluF8, pg8::DenseSched>(lds, 1024, 1024, 1024, S, E); }
                else { pg8::DenseSched S{64, 22, G, c, (const char*)H, (const char*)(ws + WS_WGU) + (size_t)j * 5632 * 1024 * 2, (size_t)256 * 1024, (size_t)256 * 1024};
                    pg8::EpiSwigluF8b E{ACT, DFF}; pg8::gemm_phase<pg8::EpiSwigluF8b, pg8::DenseSched>(lds, 1024, 1024, 1024, S, E); } }
            SEAM(pb + 5);
            if (IN(pb + 6)) { PHASE_ENV
                if (true) { pg8::DenseSched S{64, 4, G, c, (const char*)ACT, (const char*)(ws + WS_WDN) + (size_t)j * 1024 * DFF * 2, (size_t)256 * DFF, (size_t)256 * DFF};
                    pg8::EpiFuseT<true> E{(const bf16_t*)XA, (bf16_t*)a->out, H, (const float*)(ws + WS_MODF), a->in[I_FPOSTG] + l * 1024, a->in[I_MPREG] + (l + 1) * 1024, l, l + 1, 5120, 1024, 0,
                                          (f32x4*)(ws + WS_OEX) + (size_t)(2 + (l >> 1)) * 65536, ctl + CW_CNT + (2 + (l >> 1)) * 64, ctl + CW_BAR + XB_TMO, l == 2 ? 1 : 0, l == 2 ? nullptr : (unsigned char*)(ws + WS_HG8)};
                    pg8::gemm_phase<pg8::EpiFuseT<true>, pg8::DenseSched>(lds, DFF, DFF, DFF, S, E); }
                else { pg8::DenseSched S{64, 4, G, c, (const char*)ACT, (const char*)(ws + WS_WDN) + (size_t)j * 1024 * DFF * 2, (size_t)256 * DFF * 2, (size_t)256 * DFF * 2};
                    pg8::EpiFuse E{(const bf16_t*)XA, (bf16_t*)a->out, H, (const float*)(ws + WS_MODF), a->in[I_FPOSTG] + l * 1024, a->in[I_MPREG] + (l + 1) * 1024, l, l + 1, 5120, 1024, 0,
                                   (f32x4*)(ws + WS_OEX) + (size_t)(2 + (l >> 1)) * 65536, ctl + CW_CNT + (2 + (l >> 1)) * 64, ctl + CW_BAR + XB_TMO, 0, (unsigned char*)(ws + WS_HG8)};
                    pg8::gemm_phase<pg8::EpiFuse, pg8::DenseSched>(lds, DFF, DFF, DFF, S, E); } }
        }
        if (l & 1) SEAM(pb + 6);
        if ((l & 1) && IN(pb + 7)) { PHASE_ENV ThinP P{}; P.xsrc = nullptr; P.xsrcb = (const bf16_t*)XA; P.xdst = l == NLAYER - 1 ? a->out : nullptr; P.xdstb = (bf16_t*)a->out; P.post = (l & 1) ? 2 : 1; P.y = Y; P.oe = OE; P.gpost = a->in[I_FPOSTG] + l * 1024; P.lpost = l; P.gate_off = 5120;
            P.pre = l < NLAYER - 1 ? 1 : 0; P.gpre = a->in[I_MPREG] + (l + 1) * 1024; P.lpre = l + 1; P.sh_off = 0; P.sc_off = 1024; P.H = l == 1 ? nullptr : H; P.H8 = l == 1 ? (unsigned char*)H : nullptr; P.route = 0; P.cnt = ctl + CW_WCNT + j * 2048; P.from_partials = 0;
            thin_phase<true>(lds, a, P); }
        SEAM(pb + 7);
    }
#undef IN
#undef SEAM
}
extern "C" void kernel_launch(void* const* d_in, const int* in_sizes, int n_in, void* d_out, int out_size, void* d_ws, size_t ws_size, hipStream_t stream) {
    static int grid = 0;
    if (grid == 0) {
        if (n_in != 27 || out_size != MTOK * DM || ws_size < WS_END) { fprintf(stderr, "kernel_launch: bad sizes n_in %d out %d ws %zu need %zu\n", n_in, out_size, ws_size, (size_t)WS_END); grid = -1; return; }
        int dev = 0, cus = 0;
        if (hipGetDevice(&dev) != hipSuccess || hipDeviceGetAttribute(&cus, hipDeviceAttributeMultiprocessorCount, dev) != hipSuccess) { grid = -1; return; }
        if (hipFuncSetAttribute((const void*)fwd_kernel, hipFuncAttributeMaxDynamicSharedMemorySize, LDS_BYTES) != hipSuccess) { grid = -1; return; }
        int nb = 0;
        if (hipOccupancyMaxActiveBlocksPerMultiprocessor(&nb, (const void*)fwd_kernel, 512, LDS_BYTES) != hipSuccess || nb < 1) { fprintf(stderr, "kernel_launch: occupancy query %d\n", nb); grid = -1; return; }
        if (cus != 256) { fprintf(stderr, "kernel_launch: %d CUs (the fused row-panel epilogues are laid out for 256 workgroups)\n", cus); grid = -1; return; }
        grid = cus;
    }
    if (grid < 0) return;
    hipMemsetAsync((char*)d_ws + WS_CTL, 0, CTL_BYTES, stream);
    Args a{};
    for (int i = 0; i < 27; ++i) a.in[i] = (const float*)d_in[i];
    a.out = (float*)d_out; a.ws = (unsigned char*)d_ws; a.ph_lo = 0; a.ph_hi = NPHASE; a.dbg = 0; a.pad = 0;
    hipLaunchKernelGGL(fwd_kernel, dim3(grid), dim3(512), LDS_BYTES, stream, a);
}
```
